# Optimizing an MI355X kernel written in HIP

```python
import math
import jax, jax.numpy as jnp
from jax import lax
import numpy as np


D_MODEL = 1024
BATCH = 4
SEQ = 4096
DEPTH = 4
DEC_BATCH = 128
DEC_SEQ = 8
PAST_LEN = 8192
PAGE_SIZE = 128

N_A = DEPTH // 2
N_B = DEPTH - N_A
D_RNN = D_MODEL
N_LRU_BLOCKS = 4
LRU_BW = D_RNN // N_LRU_BLOCKS
CONV_W = 4
C_GATE = 8.0
N_HEADS = 16
N_KV_HEADS = 4
HEAD_DIM = 64
GROUP = N_HEADS // N_KV_HEADS
WINDOW = 128
ATTN_BLOCK = WINDOW
N_BUCKETS = 32
MAX_DISTANCE = 128
D_FF = 3 * D_MODEL
FFN_CONV_W = 3
EPS = 1e-6
NEG_INF = -1e30

kernel_name = "yoco_rglru_swa_sink_convffn_step"


def rmsnorm(x, g):
    xf = x.astype(jnp.float32)
    y = xf * lax.rsqrt(jnp.mean(xf * xf, axis=-1, keepdims=True) + EPS)
    return (y * g.astype(jnp.float32)).astype(x.dtype)


def causal_dwconv(x, buf, w, b):
    T = x.shape[1]
    W = w.shape[0]
    xp = jnp.concatenate([buf.astype(x.dtype), x], axis=1)
    y = b
    for k in range(W):
        y = y + w[k] * xp[:, k:k + T]
    return y, xp[:, T:]


def lru_scan(a, b, h0):
    def step(h, ab):
        a_t, b_t = ab
        h = a_t * h + b_t
        return h, h
    h_last, hs = lax.scan(step, h0, (jnp.swapaxes(a, 0, 1), jnp.swapaxes(b, 0, 1)))
    return jnp.swapaxes(hs, 0, 1), h_last


def rglru_block(xn, h0, conv_buf, w_in, conv_w, conv_b, gr_w, gr_b, gi_w, gi_b, lam, w_out):
    B, T, _ = xn.shape
    u = xn @ w_in
    gate, xb = u[..., :D_RNN], u[..., D_RNN:]
    xc, new_buf = causal_dwconv(xb, conv_buf, conv_w, conv_b)
    xblk = xc.reshape(B, T, N_LRU_BLOCKS, LRU_BW)
    r = jax.nn.sigmoid(jnp.einsum('btnc,ncd->btnd', xblk, gr_w).reshape(B, T, D_RNN) + gr_b)
    i = jax.nn.sigmoid(jnp.einsum('btnc,ncd->btnd', xblk, gi_w).reshape(B, T, D_RNN) + gi_b)
    log_a = -C_GATE * r.astype(jnp.float32) * jax.nn.softplus(-lam.astype(jnp.float32))
    a = jnp.exp(log_a)
    b = jnp.sqrt(-jnp.expm1(2.0 * log_a)) * (i * xc).astype(jnp.float32)
    hs, h_last = lru_scan(a, b, h0.astype(jnp.float32))
    y = (jax.nn.gelu(gate) * hs.astype(xn.dtype)) @ w_out
    return y, h_last.astype(h0.dtype), new_buf.astype(conv_buf.dtype)


def conv_ffn(xn, buf, w_up, conv_w, conv_b, w_down):
    u = xn @ w_up
    g, v = u[..., :D_FF], u[..., D_FF:]
    gc, new_buf = causal_dwconv(g, buf, conv_w, conv_b)
    return (jax.nn.gelu(gc) * v) @ w_down, new_buf.astype(buf.dtype)


def rel_bucket(dist):
    max_exact = N_BUCKETS // 2
    d = jnp.maximum(dist, 0)
    df = jnp.maximum(d, 1).astype(jnp.float32)
    large = max_exact + (jnp.log(df / max_exact) / math.log(MAX_DISTANCE / max_exact)
                         * (N_BUCKETS - max_exact)).astype(jnp.int32)
    large = jnp.minimum(large, N_BUCKETS - 1)
    return jnp.where(d < max_exact, d, large)


def rel_bias_heads(rel_bias, dist):
    b = rel_bias.astype(jnp.float32)[rel_bucket(dist)]
    Q, S = dist.shape
    return jnp.moveaxis(b, -1, 0).reshape(N_KV_HEADS, GROUP, Q, S)


def sink_softmax(scores, sinks):
    s = sinks.astype(jnp.float32)[:, :, None]
    m = jnp.maximum(jnp.max(scores, axis=-1), s)
    p = jnp.exp(scores - m[..., None])
    denom = jnp.sum(p, axis=-1) + jnp.exp(s - m)
    return p / denom[..., None]


def swa_prompt(q, k, v, sinks, rel_bias):
    B, S = q.shape[0], q.shape[1]
    nb = S // ATTN_BLOCK
    qb = q.reshape(B, nb, ATTN_BLOCK, N_KV_HEADS, GROUP, HEAD_DIM)
    kc = k.reshape(B, nb, ATTN_BLOCK, N_KV_HEADS, HEAD_DIM)
    vc = v.reshape(B, nb, ATTN_BLOCK, N_KV_HEADS, HEAD_DIM)
    kb = jnp.concatenate([jnp.concatenate([jnp.zeros_like(kc[:, :1]), kc[:, :-1]], axis=1), kc], axis=2)
    vb = jnp.concatenate([jnp.concatenate([jnp.zeros_like(vc[:, :1]), vc[:, :-1]], axis=1), vc], axis=2)
    scores = jnp.einsum('bnqkgd,bnskd->bnkgqs', qb, kb,
                        preferred_element_type=jnp.float32) * (HEAD_DIM ** -0.5)
    qi = jnp.arange(ATTN_BLOCK)[:, None]
    sj = jnp.arange(2 * ATTN_BLOCK)[None, :]
    dist = qi + ATTN_BLOCK - sj
    band = (dist >= 0) & (dist < WINDOW)
    has_prev = (jnp.arange(nb)[:, None, None] > 0) | (sj >= ATTN_BLOCK)[None]
    valid = band[None] & has_prev
    scores = jnp.where(valid[None, :, None, None], scores + rel_bias_heads(rel_bias, dist), NEG_INF)
    probs = sink_softmax(scores, sinks.reshape(N_KV_HEADS, GROUP))
    out = jnp.einsum('bnkgqs,bnskd->bnqkgd', probs.astype(v.dtype), vb)
    return out.reshape(B, S, N_HEADS * HEAD_DIM)


def swa_sample(q, k_all, v_all, sinks, rel_bias):
    DB, T = q.shape[0], q.shape[1]
    L = k_all.shape[1]
    W = L - T
    qg = q.reshape(DB, T, N_KV_HEADS, GROUP, HEAD_DIM)
    scores = jnp.einsum('btkgd,bskd->bkgts', qg, k_all,
                        preferred_element_type=jnp.float32) * (HEAD_DIM ** -0.5)
    dist = jnp.arange(T)[:, None] + W - jnp.arange(L)[None, :]
    valid = (dist >= 0) & (dist < WINDOW)
    scores = jnp.where(valid, scores + rel_bias_heads(rel_bias, dist), NEG_INF)
    probs = sink_softmax(scores, sinks.reshape(N_KV_HEADS, GROUP))
    out = jnp.einsum('bkgts,bskd->btkgd', probs.astype(v_all.dtype), v_all)
    return out.reshape(DB, T, N_HEADS * HEAD_DIM)


def shared_kv(x, kv_norm, w_kv, b_kv, k_norm):
    B, T, _ = x.shape
    kv = rmsnorm(x, kv_norm) @ w_kv + b_kv
    hkv = N_KV_HEADS * HEAD_DIM
    k = rmsnorm(kv[..., :hkv].reshape(B, T, N_KV_HEADS, HEAD_DIM), k_norm)
    v = kv[..., hkv:].reshape(B, T, N_KV_HEADS, HEAD_DIM)
    return k, v


def trunk(x, lru_h, lru_conv, ffn_conv, win_k, win_v, P, prompt):
    B, T, _ = x.shape
    new_h, new_c, new_f = [], [], []
    k = v = new_k = new_v = None
    for layer in range(DEPTH):
        if layer < N_A:
            i = layer
            y, h_i, c_i = rglru_block(rmsnorm(x, P['a_norm'][i]), lru_h[i], lru_conv[i],
                                      P['a_w_in'][i], P['a_conv_w'][i], P['a_conv_b'][i],
                                      P['a_gate_r_w'][i], P['a_gate_r_b'][i],
                                      P['a_gate_i_w'][i], P['a_gate_i_b'][i],
                                      P['a_lambda'][i], P['a_w_out'][i])
            new_h.append(h_i)
            new_c.append(c_i)
        else:
            j = layer - N_A
            q = rmsnorm(x, P['b_norm'][j]) @ P['w_q'][j] + P['b_q'][j]
            q = rmsnorm(q.reshape(B, T, N_HEADS, HEAD_DIM), P['q_norm'][j])
            if prompt:
                o = swa_prompt(q, k, v, P['sinks'][j], P['rel_bias'])
            else:
                o = swa_sample(q, k, v, P['sinks'][j], P['rel_bias'])
            y = o @ P['w_o'][j] + P['b_o'][j]
        x = x + y
        f, f_i = conv_ffn(rmsnorm(x, P['f_norm'][layer]), ffn_conv[layer], P['f_w_up'][layer],
                          P['f_conv_w'][layer], P['f_conv_b'][layer], P['f_w_down'][layer])
        new_f.append(f_i)
        x = x + f
        if layer == N_A - 1:
            k, v = shared_kv(x, P['kv_norm'], P['w_kv'], P['b_kv'], P['k_norm'])
            if not prompt:
                k = jnp.concatenate([win_k.astype(k.dtype), k], axis=1)
                v = jnp.concatenate([win_v.astype(v.dtype), v], axis=1)
            new_k = k[:, -WINDOW:]
            new_v = v[:, -WINDOW:]
    return x, jnp.stack(new_h), jnp.stack(new_c), jnp.stack(new_f), new_k, new_v


def setup_inputs(seed: int = 0) -> dict:
    key = jax.random.key(seed)
    ks = iter(jax.random.split(key, 48))

    def nrm(shape, scale):
        return scale * jax.random.normal(next(ks), shape, jnp.float32)

    def gain(shape):
        return 1.0 + nrm(shape, 0.05)

    HQ = N_HEADS * HEAD_DIM
    HKV = N_KV_HEADS * HEAD_DIM
    a_c = jax.random.uniform(next(ks), (N_A, D_RNN), jnp.float32, 0.9, 0.999)
    a_base = jnp.exp(jnp.log(a_c) / C_GATE)
    a_lambda = jnp.log(a_base) - jnp.log1p(-a_base)
    return {
        "x_prompt": nrm((BATCH, SEQ, D_MODEL), 1.0),
        "x_sample": nrm((DEC_BATCH, DEC_SEQ, D_MODEL), 1.0),
        "state_lru_h": nrm((N_A, DEC_BATCH, D_RNN), 0.5),
        "state_lru_conv": nrm((N_A, DEC_BATCH, CONV_W - 1, D_RNN), 0.5),
        "state_ffn_conv": nrm((DEPTH, DEC_BATCH, FFN_CONV_W - 1, D_FF), 0.5),
        "cache_k_win": nrm((DEC_BATCH, WINDOW, N_KV_HEADS, HEAD_DIM), 1.0),
        "cache_v_win": nrm((DEC_BATCH, WINDOW, N_KV_HEADS, HEAD_DIM), 1.0),
        "a_norm": gain((N_A, D_MODEL)),
        "a_w_in": nrm((N_A, D_MODEL, 2 * D_RNN), D_MODEL ** -0.5),
        "a_conv_w": nrm((N_A, CONV_W, D_RNN), CONV_W ** -0.5),
        "a_conv_b": nrm((N_A, D_RNN), 0.02),
        "a_gate_r_w": nrm((N_A, N_LRU_BLOCKS, LRU_BW, LRU_BW), LRU_BW ** -0.5),
        "a_gate_r_b": nrm((N_A, D_RNN), 0.02),
        "a_gate_i_w": nrm((N_A, N_LRU_BLOCKS, LRU_BW, LRU_BW), LRU_BW ** -0.5),
        "a_gate_i_b": nrm((N_A, D_RNN), 0.02),
        "a_lambda": a_lambda,
        "a_w_out": nrm((N_A, D_RNN, D_MODEL), D_RNN ** -0.5),
        "kv_norm": gain((D_MODEL,)),
        "w_kv": nrm((D_MODEL, 2 * HKV), D_MODEL ** -0.5),
        "b_kv": nrm((2 * HKV,), 0.02),
        "k_norm": gain((HEAD_DIM,)),
        "b_norm": gain((N_B, D_MODEL)),
        "w_q": nrm((N_B, D_MODEL, HQ), D_MODEL ** -0.5),
        "b_q": nrm((N_B, HQ), 0.02),
        "q_norm": gain((N_B, HEAD_DIM)),
        "sinks": nrm((N_B, N_HEADS), 0.5),
        "w_o": nrm((N_B, HQ, D_MODEL), HQ ** -0.5),
        "b_o": nrm((N_B, D_MODEL), 0.02),
        "rel_bias": nrm((N_BUCKETS, N_HEADS), 0.5),
        "f_norm": gain((DEPTH, D_MODEL)),
        "f_w_up": nrm((DEPTH, D_MODEL, 2 * D_FF), D_MODEL ** -0.5),
        "f_conv_w": nrm((DEPTH, FFN_CONV_W, D_FF), FFN_CONV_W ** -0.5),
        "f_conv_b": nrm((DEPTH, D_FF), 0.02),
        "f_w_down": nrm((DEPTH, D_FF, D_MODEL), D_FF ** -0.5),
    }


def reference(x_prompt, x_sample, state_lru_h, state_lru_conv, state_ffn_conv, cache_k_win, cache_v_win,
              a_norm, a_w_in, a_conv_w, a_conv_b, a_gate_r_w, a_gate_r_b, a_gate_i_w, a_gate_i_b,
              a_lambda, a_w_out, kv_norm, w_kv, b_kv, k_norm, b_norm, w_q, b_q, q_norm, sinks,
              w_o, b_o, rel_bias, f_norm, f_w_up, f_conv_w, f_conv_b, f_w_down):
    P = dict(a_norm=a_norm, a_w_in=a_w_in, a_conv_w=a_conv_w, a_conv_b=a_conv_b,
             a_gate_r_w=a_gate_r_w, a_gate_r_b=a_gate_r_b, a_gate_i_w=a_gate_i_w, a_gate_i_b=a_gate_i_b,
             a_lambda=a_lambda, a_w_out=a_w_out, kv_norm=kv_norm, w_kv=w_kv, b_kv=b_kv, k_norm=k_norm,
             b_norm=b_norm, w_q=w_q, b_q=b_q, q_norm=q_norm, sinks=sinks, w_o=w_o, b_o=b_o,
             rel_bias=rel_bias, f_norm=f_norm, f_w_up=f_w_up, f_conv_w=f_conv_w, f_conv_b=f_conv_b,
             f_w_down=f_w_down)
    B = x_prompt.shape[0]
    dt = x_prompt.dtype
    zero_h = jnp.zeros((N_A, B, D_RNN), dt)
    zero_c = jnp.zeros((N_A, B, CONV_W - 1, D_RNN), dt)
    zero_f = jnp.zeros((DEPTH, B, FFN_CONV_W - 1, D_FF), dt)
    y_prompt, h_p, c_p, f_p, k_p, v_p = trunk(x_prompt, zero_h, zero_c, zero_f, None, None, P, True)
    y_sample, h_s, c_s, f_s, k_s, v_s = trunk(x_sample, state_lru_h, state_lru_conv, state_ffn_conv,
                                              cache_k_win, cache_v_win, P, False)
    return (y_prompt, y_sample, h_p, c_p, f_p, k_p, v_p, h_s, c_s, f_s, k_s, v_s)
```

```cpp
#include <hip/hip_runtime.h>
#include <cstdio>
#include <cstdint>

#ifndef MK_PER_PHASE
#define MK_PER_PHASE 0
#endif

#ifndef PROBE_KIND
#define PROBE_KIND -1
#endif
#ifndef PROBE_REP
#define PROBE_REP 1
#endif
#ifdef PROBE_NOSMALL
#define PROBE_SKIP_SMALL probe_extra
#else
#define PROBE_SKIP_SMALL false
#endif
#define LAS __attribute__((address_space(3)))
#define GAS __attribute__((address_space(1)))
typedef _Float16 f16;
typedef _Float16 f16x2 __attribute__((ext_vector_type(2)));
typedef _Float16 f16x4 __attribute__((ext_vector_type(4)));
typedef _Float16 f16x8 __attribute__((ext_vector_type(8)));
typedef float f32x2 __attribute__((ext_vector_type(2)));
typedef float f32x4 __attribute__((ext_vector_type(4)));
typedef float f32x16 __attribute__((ext_vector_type(16)));
typedef unsigned u32x2 __attribute__((ext_vector_type(2)));
typedef unsigned u32x4 __attribute__((ext_vector_type(4)));
typedef short s16x4 __attribute__((ext_vector_type(4)));
typedef GAS unsigned gu32;

constexpr int MP = 16384, MS = 1024, M = MP + MS, D = 1024, FF = 3072, SEQ = 4096, TS = 8, NDB = 128;
constexpr float EPS = 1e-6f;
constexpr float LOG2E = 1.4426950408889634f;
constexpr float QSCALE = 0.125f * LOG2E;

constexpr size_t O_Y = 0, O_HP = 17825792, O_CP = 17833984, O_FP = 17858560, O_KP = 17956864, O_VP = 18087936,
                 O_HS = 18219008, O_CS = 18481152, O_FS = 19267584, O_KS = 22413312, O_VS = 26607616, O_END = 30801920;

constexpr size_t MiB = 1u << 20;
constexpr size_t WS_CTL = 0, CTL_ZERO_BYTES = 65536;
constexpr size_t WS_WIN = 2 * MiB;
constexpr size_t WS_WG = 10 * MiB;
constexpr size_t WS_WOUT = 12 * MiB;
constexpr size_t WS_WUP = 16 * MiB;
constexpr size_t WS_WDN = 64 * MiB;
constexpr size_t WS_WKV = 88 * MiB;
constexpr size_t WS_WQ = 89 * MiB;
constexpr size_t WS_WO = 93 * MiB;
constexpr size_t WS_CONST = 97 * MiB;
constexpr size_t WS_SS = 98 * MiB;
constexpr size_t WS_PH = 100 * MiB;
constexpr size_t WS_X16 = 102 * MiB;
constexpr size_t WS_K16 = 136 * MiB, WS_V16 = 144 * MiB;
constexpr size_t WS_KS16 = 152 * MiB, WS_VS16 = 162 * MiB;
constexpr size_t WS_GF = 172 * MiB, WS_VF = 175 * MiB, WS_GL = 178 * MiB;
constexpr size_t WS_XF = WS_GF, WS_XL = WS_VF;
constexpr size_t WS_R1 = 182 * MiB;
constexpr size_t WS_GG = WS_R1, WS_XB = WS_R1 + 34 * MiB, WS_XC = WS_R1 + 68 * MiB, WS_LA = WS_R1 + 102 * MiB, WS_BB = WS_R1 + 136 * MiB;
constexpr size_t WS_Y16 = WS_XB;
constexpr size_t WS_Q16 = WS_R1, WS_O16 = WS_R1 + 34 * MiB;
constexpr size_t WS_H16 = WS_R1;
constexpr size_t WS_END = WS_R1 + 170 * MiB;

constexpr int C_SP2 = 0;
constexpr int C_BIAS2 = 2048;
constexpr int C_SINK2 = 4096;

constexpr int CW_BAR = 4096;

constexpr int RING_BYTES = 131072;
constexpr int LDS_BYTES = 155648;
constexpr int LDSCTL_OFF = LDS_BYTES - 1024, MISC_OFF = LDSCTL_OFF + 320;

__device__ __forceinline__ unsigned pk2h(float lo, float hi) { f32x2 v = {lo, hi}; f16x2 h = __builtin_convertvector(v, f16x2); return __builtin_bit_cast(unsigned, h); }
__device__ __forceinline__ void ld8(const f16* p, float (&o)[8]) { const f16x8 v = *(const f16x8*)p;
#pragma unroll
    for (int i = 0; i < 8; ++i) o[i] = (float)v[i]; }
__device__ __forceinline__ void st8(f16* p, const float (&v)[8]) { u32x4 w; w.x = pk2h(v[0], v[1]); w.y = pk2h(v[2], v[3]); w.z = pk2h(v[4], v[5]); w.w = pk2h(v[6], v[7]); *(u32x4*)p = w; }
__device__ __forceinline__ float gelu_t(float x) {
    const float e = __builtin_amdgcn_exp2f(x * (-2.302208198f - 0.10294324f * x * x));
    return x * __builtin_amdgcn_rcpf(1.0f + e);
}
__device__ __forceinline__ float sigmoid_f(float x) { return __builtin_amdgcn_rcpf(1.0f + __builtin_amdgcn_exp2f(-LOG2E * x)); }
template <int CTRL> __device__ __forceinline__ float dppf(float v) { return __builtin_bit_cast(float, __builtin_amdgcn_update_dpp(0, __builtin_bit_cast(int, v), CTRL, 0xf, 0xf, false)); }
#define SHR1 0x111
#define SHR2 0x112
#define SHR4 0x114
#define SHR8 0x118
template <int CTRL> __device__ __forceinline__ float dpp1(float v) { return __builtin_bit_cast(float, __builtin_amdgcn_update_dpp(0x3f800000, __builtin_bit_cast(int, v), CTRL, 0xf, 0xf, false)); }
template <int CTRL> __device__ __forceinline__ float dppz(float v) { return __builtin_bit_cast(float, __builtin_amdgcn_update_dpp(0, __builtin_bit_cast(int, v), CTRL, 0xf, 0xf, true)); }
__device__ __forceinline__ float xor16f(float v) { return __builtin_bit_cast(float, __builtin_amdgcn_ds_swizzle(__builtin_bit_cast(int, v), 0x401F)); }
__device__ __forceinline__ float other32f(float v) { const unsigned u = __builtin_bit_cast(unsigned, v); auto r = __builtin_amdgcn_permlane32_swap(u, u, false, false);
    return __builtin_bit_cast(float, r[0] ^ r[1] ^ u); }
__device__ __forceinline__ float sum16_32(float v) { v += xor16f(v); return v + other32f(v); }
__device__ __forceinline__ float sum8(float v) { v += dppf<0xB1>(v); v += dppf<0x4E>(v); return v + dppf<0x141>(v); }
#define ROR1 0x121
#define ROR2 0x122
#define ROR3 0x123

#ifndef PG8_SP2
#define PG8_SP2 1
#endif
#ifndef PG8_ALIGN
#define PG8_ALIGN 1
#endif
namespace pg8 {
constexpr int BM = 256, BK = 64, HALF = 128, HTB = HALF * BK * 2, STAGE_BYTES = 8 * HTB, NXCD = 8, WGM = 8;
__host__ __device__ __forceinline__ int lds_byte(int r, int c) { const int st = (r >> 4) * 2 + (c >> 5), rr = r & 15, cc = c & 31, ob = rr * 64 + cc * 2; return st * 1024 + (ob ^ (((ob >> 9) & 1) << 5)); }
__host__ __device__ __forceinline__ void stage_rc(int b, int& R, int& C) { const int st = b / 1024, sb = b % 1024, swz = sb ^ (((sb >> 9) & 1) << 5); R = (st >> 1) * 16 + swz / 64; C = (st & 1) * 32 + (swz % 64) / 2; }
__host__ __device__ __forceinline__ int perm32(int rho) { const int n = rho >> 4, i = rho & 15; return 8 * (i >> 2) + 4 * n + (i & 3); }

struct Unit { int pm, pn; };
struct Gemm { const f16* A; const f16* Bt; int M, N, K, lda, amode; };

struct StaticOrder {
    int nM, nN, nwg, G, c; bool lin;
    __device__ void init(int M_, int N_, int G_, int c_, bool lin_ = false) { nM = M_ / BM; nN = N_ / BM; nwg = nM * nN; G = G_; c = c_; lin = lin_; }
    __device__ bool next(int i, Unit& u) const {
        const long L = (long)i * G + c; if (L >= nwg) return false;
        if (lin) { u.pm = (int)(L % nM); u.pn = (int)(L / nM); return true; }
        int wgid = (int)L; { const int q = nwg / NXCD, r = nwg % NXCD, xcd = wgid % NXCD, off = wgid / NXCD; wgid = (xcd < r ? xcd * (q + 1) : r * (q + 1) + (xcd - r) * q) + off; }
        const int nig = WGM * nN, gid = wgid / nig, fm = gid * WGM, gsz = (nM - fm) < WGM ? (nM - fm) : WGM;
        u.pm = fm + ((wgid % nig) % gsz); u.pn = (wgid % nig) / gsz; return true;
    }
};

template <class Epi>
__device__ __forceinline__ void gemm_phase(LAS unsigned char* lds, const Gemm g, const StaticOrder& S, const Epi& E, const int tid) {
    const int wid = __builtin_amdgcn_readfirstlane(tid >> 6), lane = tid & 63, wr = wid >> 2, wc = wid & 3, fr = lane & 15, fq = lane >> 4;
    const int K = g.K, nt = K / BK, lda = g.lda;
    unsigned voffA[2], voffB[2];
#pragma unroll
    for (int i = 0; i < 2; ++i) { int R, C; stage_rc(tid * 16 + i * 8192, R, C); const int Rb = Epi::PERM ? ((R & ~31) + perm32(R & 31)) : R;
        const int Ra = (R & ~63) + 4 * (R & 15) + ((R >> 4) & 3);
        voffA[i] = (unsigned)(Ra * lda + C) * 2u; voffB[i] = (unsigned)(Rb * K + C) * 2u; }
    const size_t kstep = (size_t)(BK * 2);
    const size_t hstepA = (size_t)HALF * lda * 2, hstepB = (size_t)HALF * K * 2;
    const size_t tstepA = 2 * hstepA, tstepB = 2 * hstepB;
    const unsigned ldsw = (unsigned)wid * 1024u;
    const int aoff = lds_byte(wr * 64 + fr, fq * 8), boff = lds_byte(wc * 32 + fr, fq * 8);
#define PG8_SA(b, h) (((b) * 2 + (h)) * HTB)
#define PG8_SB(b, h) ((4 + (b) * 2 + (h)) * HTB)
#define PG8_STAGE(bufoff, gbase, voff) do { _Pragma("unroll") for (int _i = 0; _i < 2; ++_i) \
        __builtin_amdgcn_global_load_lds((const unsigned*)((const char*)(gbase) + (voff)[_i]), (LAS unsigned*)(lds + (bufoff) + ldsw + _i * 8192), 16, 0, 0); } while (0)
#define PG8_LDA(dst, b, h) do { _Pragma("unroll") for (int m = 0; m < 4; ++m) _Pragma("unroll") for (int k = 0; k < 2; ++k) dst[m][k] = *(const LAS f16x8*)(lds + PG8_SA(b, h) + aoff + m * 2048 + k * 1024); } while (0)
#define PG8_LDB(dst, b, h) do { _Pragma("unroll") for (int n = 0; n < 2; ++n) _Pragma("unroll") for (int k = 0; k < 2; ++k) dst[n][k] = *(const LAS f16x8*)(lds + PG8_SB(b, h) + boff + n * 2048 + k * 1024); } while (0)
#define PG8_MMA(ai, bj, At, Bt) do { __builtin_amdgcn_s_setprio(1); _Pragma("unroll") for (int m = 0; m < 4; ++m) _Pragma("unroll") for (int n = 0; n < 2; ++n) _Pragma("unroll") for (int k = 0; k < 2; ++k) \
        acc[ai][bj][m][n] = __builtin_amdgcn_mfma_f32_16x16x32_f16(Bt[n][k], At[m][k], acc[ai][bj][m][n], 0, 0, 0); __builtin_amdgcn_s_setprio(0); } while (0)
#define PG8_WAIT_V(n) asm volatile("s_waitcnt vmcnt(" #n ")" ::: "memory")
#define PG8_WAIT_L(n) asm volatile("s_waitcnt lgkmcnt(" #n ")" ::: "memory")
#define PG8_BAR __builtin_amdgcn_s_barrier()
#define PG8_SCHED __builtin_amdgcn_sched_barrier(0)
#define PG8_ACOL(u) ((size_t)(g.amode ? (((u).pn >> 1) * 256 * 2) : 0))
    Unit cur, nxt; int ui = 0;
    if (!S.next(0, cur)) return;
    f32x4 acc[2][2][4][2];
#pragma unroll
    for (int a = 0; a < 2; ++a)
#pragma unroll
        for (int b = 0; b < 2; ++b)
#pragma unroll
            for (int m = 0; m < 4; ++m)
#pragma unroll
                for (int n = 0; n < 2; ++n) acc[a][b][m][n] = (f32x4){0.f, 0.f, 0.f, 0.f};
    f16x8 At[4][2], B0[2][2], B1[2][2];
    const char* cA = (const char*)g.A + (size_t)cur.pm * tstepA + PG8_ACOL(cur); const char* cB = (const char*)g.Bt + (size_t)cur.pn * tstepB;
#if PG8_SP2
    PG8_STAGE(PG8_SB(0, 0), cB, voffB); PG8_STAGE(PG8_SB(0, 1), cB + hstepB, voffB); PG8_STAGE(PG8_SA(0, 0), cA, voffA); PG8_STAGE(PG8_SA(0, 1), cA + hstepA, voffA);
    if (wr == 1) PG8_BAR;
    PG8_WAIT_V(2); PG8_BAR;
    PG8_STAGE(PG8_SB(1, 0), cB + kstep, voffB); PG8_STAGE(PG8_SA(1, 0), cA + kstep, voffA); PG8_STAGE(PG8_SB(1, 1), cB + hstepB + kstep, voffB);
    PG8_WAIT_V(6); PG8_BAR;
#else
    PG8_STAGE(PG8_SB(0, 0), cB, voffB); PG8_STAGE(PG8_SA(0, 0), cA, voffA); PG8_STAGE(PG8_SB(0, 1), cB + hstepB, voffB); PG8_STAGE(PG8_SA(0, 1), cA + hstepA, voffA);
    if (wr == 1) PG8_BAR;
    PG8_WAIT_V(4); PG8_BAR;
    PG8_STAGE(PG8_SB(1, 0), cB + kstep, voffB); PG8_STAGE(PG8_SA(1, 0), cA + kstep, voffA); PG8_STAGE(PG8_SB(1, 1), cB + hstepB + kstep, voffB);
    PG8_WAIT_V(6); PG8_BAR;
#endif
    for (;;) {
        const bool has_next = S.next(ui + 1, nxt);
        const char* nA = has_next ? (const char*)g.A + (size_t)nxt.pm * tstepA + PG8_ACOL(nxt) : cA; const char* nB = has_next ? (const char*)g.Bt + (size_t)nxt.pn * tstepB : cB;
#pragma unroll 1
        for (int t = 0; t < nt; t += 2) {
            const bool last = (t == nt - 2);
            const char* a1 = cA + (size_t)(t + 1) * kstep;
            const char* a2 = last ? nA : cA + (size_t)(t + 2) * kstep; const char* b2 = last ? nB : cB + (size_t)(t + 2) * kstep;
            const char* a3 = a2 + kstep; const char* b3 = b2 + kstep;
#if PG8_SP2
            PG8_LDB(B0, 0, 0); PG8_LDB(B1, 0, 1); PG8_SCHED; PG8_LDA(At, 0, 0); PG8_STAGE(PG8_SA(1, 1), a1 + hstepA, voffA);
            PG8_WAIT_V(8); PG8_WAIT_L(0); PG8_BAR; PG8_MMA(0, 0, At, B0); PG8_MMA(0, 1, At, B1); PG8_BAR; PG8_SCHED;
            PG8_LDA(At, 0, 1); PG8_STAGE(PG8_SB(0, 0), b2, voffB); PG8_STAGE(PG8_SB(0, 1), b2 + hstepB, voffB); PG8_STAGE(PG8_SA(0, 0), a2, voffA);
            PG8_WAIT_V(8); PG8_WAIT_L(0); PG8_BAR; PG8_MMA(1, 0, At, B0); PG8_MMA(1, 1, At, B1); PG8_BAR; PG8_SCHED;
            PG8_LDB(B0, 1, 0); PG8_LDB(B1, 1, 1); PG8_SCHED; PG8_LDA(At, 1, 0); PG8_STAGE(PG8_SA(0, 1), a2 + hstepA, voffA);
            PG8_WAIT_V(8); PG8_WAIT_L(0); PG8_BAR; PG8_MMA(0, 0, At, B0); PG8_MMA(0, 1, At, B1); PG8_BAR; PG8_SCHED;
            PG8_LDA(At, 1, 1); PG8_STAGE(PG8_SB(1, 0), b3, voffB); PG8_STAGE(PG8_SB(1, 1), b3 + hstepB, voffB); PG8_STAGE(PG8_SA(1, 0), a3, voffA);
            PG8_WAIT_V(8); PG8_WAIT_L(0); PG8_BAR; PG8_MMA(1, 0, At, B0); PG8_MMA(1, 1, At, B1); PG8_BAR; PG8_SCHED;
        #else
            PG8_LDB(B0, 0, 0); PG8_SCHED; PG8_LDA(At, 0, 0); PG8_STAGE(PG8_SA(1, 1), a1 + hstepA, voffA);
            PG8_WAIT_L(8); PG8_BAR; PG8_WAIT_L(0); PG8_MMA(0, 0, At, B0); PG8_BAR; PG8_SCHED;
            PG8_LDB(B1, 0, 1); PG8_STAGE(PG8_SB(0, 0), b2, voffB);
            PG8_BAR; PG8_WAIT_L(0); PG8_MMA(0, 1, At, B1); PG8_BAR;
            PG8_LDA(At, 0, 1); PG8_STAGE(PG8_SA(0, 0), a2, voffA);
            PG8_BAR; PG8_WAIT_L(0); PG8_MMA(1, 0, At, B0); PG8_BAR; PG8_SCHED;
            PG8_STAGE(PG8_SB(0, 1), b2 + hstepB, voffB);
            PG8_WAIT_V(6); PG8_BAR; PG8_MMA(1, 1, At, B1); PG8_BAR;
            PG8_LDB(B0, 1, 0); PG8_SCHED; PG8_LDA(At, 1, 0); PG8_STAGE(PG8_SA(0, 1), a2 + hstepA, voffA);
            PG8_WAIT_L(8); PG8_BAR; PG8_WAIT_L(0); PG8_MMA(0, 0, At, B0); PG8_BAR; PG8_SCHED;
            PG8_LDB(B1, 1, 1); PG8_STAGE(PG8_SB(1, 0), b3, voffB);
            PG8_BAR; PG8_WAIT_L(0); PG8_MMA(0, 1, At, B1); PG8_BAR;
            PG8_LDA(At, 1, 1); PG8_STAGE(PG8_SA(1, 0), a3, voffA);
            PG8_BAR; PG8_WAIT_L(0); PG8_MMA(1, 0, At, B0); PG8_BAR; PG8_SCHED;
            PG8_STAGE(PG8_SB(1, 1), b3 + hstepB, voffB);
            PG8_WAIT_V(6); PG8_BAR; PG8_MMA(1, 1, At, B1); PG8_BAR;
#endif
        }
#if PG8_ALIGN
        if (wr == 0) PG8_BAR;
#endif
        { int z_ = 0; asm volatile("" : "+v"(z_));
          const int l2 = (int)__builtin_amdgcn_mbcnt_hi(~0u, __builtin_amdgcn_mbcnt_lo(~0u, (unsigned)z_));
          E(acc, cur, wr, wc, l2 & 15, l2 >> 4); }
        if (!has_next) break;
#pragma unroll
        for (int a = 0; a < 2; ++a)
#pragma unroll
            for (int b = 0; b < 2; ++b)
#pragma unroll
                for (int m = 0; m < 4; ++m)
#pragma unroll
                    for (int n = 0; n < 2; ++n) acc[a][b][m][n] = (f32x4){0.f, 0.f, 0.f, 0.f};
        cur = nxt; cA = nA; cB = nB; ++ui;
#if PG8_ALIGN
        if (wr == 1) PG8_BAR;
#endif
    }
    PG8_WAIT_V(0);
#if !PG8_ALIGN
    if (wr == 0) PG8_BAR;
#endif
    PG8_BAR;
#undef PG8_SA
#undef PG8_SB
#undef PG8_STAGE
#undef PG8_LDA
#undef PG8_LDB
#undef PG8_MMA
#undef PG8_WAIT_V
#undef PG8_WAIT_L
#undef PG8_BAR
#undef PG8_SCHED
#undef PG8_ACOL
}
}
using pg8::Unit;

__device__ __forceinline__ float row_rstd(const float* SS, int row, int fq) {
    const f32x4 s = *(const f32x4*)(SS + (size_t)row * 16 + fq * 4);
    float t = (s.x + s.y) + (s.z + s.w);
    t = sum16_32(t);
    return __builtin_amdgcn_rsqf(t * (1.0f / 1024.0f) + EPS);
}
#define ACC_T const f32x4 (&acc)[2][2][4][2]

__device__ __forceinline__ f16x2 h2(float a, float b) { f32x2 v = {a, b}; return __builtin_convertvector(v, f16x2); }
template <int CTRL> __device__ __forceinline__ f16x2 dpph2(f16x2 v) { return __builtin_bit_cast(f16x2, __builtin_amdgcn_mov_dpp(__builtin_bit_cast(int, v), CTRL, 0xf, 0xf, true)); }
__device__ __forceinline__ f16x2 exp2_h2(f16x2 t) { unsigned r; asm("v_exp_f16_e32 %0, %1\n\ts_nop 0\n\tv_exp_f16_sdwa %0, %1 dst_sel:WORD_1 dst_unused:UNUSED_PRESERVE src0_sel:WORD_1\n\ts_nop 0" : "=&v"(r) : "v"(t)); return __builtin_bit_cast(f16x2, r); }
__device__ __forceinline__ f16x2 rcp_h2(f16x2 t)  { unsigned r; asm("v_rcp_f16_e32 %0, %1\n\ts_nop 0\n\tv_rcp_f16_sdwa %0, %1 dst_sel:WORD_1 dst_unused:UNUSED_PRESERVE src0_sel:WORD_1\n\ts_nop 0" : "=&v"(r) : "v"(t)); return __builtin_bit_cast(f16x2, r); }
__device__ __forceinline__ f16x2 gelu_h2(f16x2 x) {
    const f16x2 c1 = {(f16)-2.302208198f, (f16)-2.302208198f}, c2 = {(f16)-0.10294324f, (f16)-0.10294324f}, one = {(f16)1.0f, (f16)1.0f};
    f16x2 t = x * x; t = t * c2 + c1; t = x * t;
    return x * rcp_h2(exp2_h2(t) + one);
}
#define SB_ __builtin_amdgcn_sched_barrier(0)
__device__ __forceinline__ void gelu4_h2(const f16x2 (&x)[4], f16x2 (&r)[4]) {
    const f16x2 c1 = {(f16)-2.302208198f, (f16)-2.302208198f}, c2 = {(f16)-0.10294324f, (f16)-0.10294324f}, one = {(f16)1.0f, (f16)1.0f};
    f16x2 t[4];
    SB_;
#pragma unroll
    for (int k = 0; k < 4; ++k) t[k] = x[k] * x[k];
    SB_;
#pragma unroll
    for (int k = 0; k < 4; ++k) t[k] = t[k] * c2 + c1;
    SB_;
#pragma unroll
    for (int k = 0; k < 4; ++k) t[k] = x[k] * t[k];
    SB_;
    unsigned e[4];
#pragma unroll
    for (int k = 0; k < 4; ++k) asm("v_exp_f16_e32 %0, %1" : "=&v"(e[k]) : "v"(t[k]));
    SB_;
#pragma unroll
    for (int k = 0; k < 4; ++k) asm("v_exp_f16_sdwa %0, %1 dst_sel:WORD_1 dst_unused:UNUSED_PRESERVE src0_sel:WORD_1" : "+v"(e[k]) : "v"(t[k]));
    SB_;
#pragma unroll
    for (int k = 0; k < 4; ++k) t[k] = __builtin_bit_cast(f16x2, e[k]) + one;
    SB_;
#pragma unroll
    for (int k = 0; k < 4; ++k) asm("v_rcp_f16_e32 %0, %1" : "=&v"(e[k]) : "v"(t[k]));
    SB_;
#pragma unroll
    for (int k = 0; k < 4; ++k) asm("v_rcp_f16_sdwa %0, %1 dst_sel:WORD_1 dst_unused:UNUSED_PRESERVE src0_sel:WORD_1" : "+v"(e[k]) : "v"(t[k]));
    SB_;
#pragma unroll
    for (int k = 0; k < 4; ++k) t[k] = __builtin_bit_cast(f16x2, e[k]);
    SB_;
#pragma unroll
    for (int k = 0; k < 4; ++k) r[k] = x[k] * t[k];
    SB_;
}
struct EpiIn {
    static constexpr bool PERM = true;
    const float* SS; f16* GG; f16* XC; f16* XF; f16* XL; const float* cw; const float* cb; float* conv_p;
    __device__ __forceinline__ void operator()(ACC_T, const Unit& u, int wr, int wc, int fr, int fq) const {
        const bool gate = u.pn < 4;
        const int col0 = (u.pn & 3) * 256 + wc * 32 + 8 * fq;
        if (gate) {
            float rsa[2][4];
#pragma unroll
            for (int ai = 0; ai < 2; ++ai)
#pragma unroll
                for (int m = 0; m < 4; ++m) rsa[ai][m] = row_rstd(SS, u.pm * 256 + ai * 128 + wr * 64 + 4 * fr + m, fq);
#pragma unroll
            for (int ai = 0; ai < 2; ++ai)
#pragma unroll
                for (int m = 0; m < 4; ++m) {
                    const int row = u.pm * 256 + ai * 128 + wr * 64 + 4 * fr + m;
                    const f16x2 rs2 = h2(rsa[ai][m], rsa[ai][m]);
#pragma unroll
                    for (int bj = 0; bj < 2; ++bj) {
                        u32x4 w;
#pragma unroll
                        for (int j = 0; j < 4; ++j) { const f16x2 x = h2(acc[ai][bj][m][j >> 1][2 * (j & 1)], acc[ai][bj][m][j >> 1][2 * (j & 1) + 1]) * rs2; w[j] = __builtin_bit_cast(unsigned, gelu_h2(x)); }
                        *(u32x4*)(GG + (size_t)row * 1024 + col0 + bj * 128) = w;
                    }
                }
        } else {
#pragma unroll
            for (int bj = 0; bj < 2; ++bj) {
                const int col = col0 + bj * 128;
                f16x2 w0[4], w1[4], w2[4], w3[4], b0[4];
#pragma unroll
                for (int j = 0; j < 4; ++j) { w0[j] = h2(cw[col + 2 * j], cw[col + 2 * j + 1]); w1[j] = h2(cw[1024 + col + 2 * j], cw[1024 + col + 2 * j + 1]); w2[j] = h2(cw[2048 + col + 2 * j], cw[2048 + col + 2 * j + 1]);
                                              w3[j] = h2(cw[3072 + col + 2 * j], cw[3072 + col + 2 * j + 1]); b0[j] = h2(cb[col + 2 * j], cb[col + 2 * j + 1]); }
#pragma unroll
                for (int ai = 0; ai < 2; ++ai) {
                    const int cidx = u.pm * 4 + ai * 2 + wr, rowb = u.pm * 256 + ai * 128 + wr * 64 + 4 * fr;
                    float rs4[4];
#pragma unroll
                    for (int m = 0; m < 4; ++m) rs4[m] = row_rstd(SS, rowb + m, fq);
                    f16x2 x[4][4];
#pragma unroll
                    for (int m = 0; m < 4; ++m) { const f16x2 rs2 = h2(rs4[m], rs4[m]);
#pragma unroll
                        for (int j = 0; j < 4; ++j) x[m][j] = h2(acc[ai][bj][m][j >> 1][2 * (j & 1)], acc[ai][bj][m][j >> 1][2 * (j & 1) + 1]) * rs2; }
                    u32x4 xc[4];
#pragma unroll
                    for (int j = 0; j < 4; ++j) {
                        const f16x2 p3 = dpph2<SHR1>(x[3][j]), p2 = dpph2<SHR1>(x[2][j]), p1 = dpph2<SHR1>(x[1][j]);
                        xc[0][j] = __builtin_bit_cast(unsigned, b0[j] + w0[j] * p1 + w1[j] * p2 + w2[j] * p3 + w3[j] * x[0][j]);
                        xc[1][j] = __builtin_bit_cast(unsigned, b0[j] + w0[j] * p2 + w1[j] * p3 + w2[j] * x[0][j] + w3[j] * x[1][j]);
                        xc[2][j] = __builtin_bit_cast(unsigned, b0[j] + w0[j] * p3 + w1[j] * x[0][j] + w2[j] * x[1][j] + w3[j] * x[2][j]);
                        xc[3][j] = __builtin_bit_cast(unsigned, b0[j] + w0[j] * x[0][j] + w1[j] * x[1][j] + w2[j] * x[2][j] + w3[j] * x[3][j]);
                    }
#pragma unroll
                    for (int m = 0; m < 4; ++m) {
                        *(u32x4*)(XC + (size_t)(rowb + m) * 1024 + col) = xc[m];
#define XR_ (u32x4){__builtin_bit_cast(unsigned, x[m][0]), __builtin_bit_cast(unsigned, x[m][1]), __builtin_bit_cast(unsigned, x[m][2]), __builtin_bit_cast(unsigned, x[m][3])}
                        if (m < 3 && fr == 0) *(u32x4*)(XF + ((size_t)cidx * 3 + m) * 1024 + col) = XR_;
                        if (m >= 1 && fr == 15) {
                            *(u32x4*)(XL + ((size_t)cidx * 3 + (m - 1)) * 1024 + col) = XR_;
                            const int t = (rowb + m) & 4095;
                            if (t >= 4093) { float* dst = conv_p + ((size_t)((rowb + m) >> 12) * 3 + (t - 4093)) * 1024 + col; *(f32x4*)dst = acc[ai][bj][m][0] * rs4[m]; *(f32x4*)(dst + 4) = acc[ai][bj][m][1] * rs4[m]; }
                        }
#undef XR_
                    }
                }
            }
        }
    }
};

__device__ __forceinline__ void gate_ab(float ar, float ai_, float cbr, float cbi, float csp, float xc, float& a, float& b) {
    const float r = __builtin_amdgcn_rcpf(1.0f + __builtin_amdgcn_exp2f(ar * -LOG2E + cbr)), ig = __builtin_amdgcn_rcpf(1.0f + __builtin_amdgcn_exp2f(ai_ * -LOG2E + cbi));
    a = __builtin_amdgcn_exp2f(-r * csp);
    b = __builtin_amdgcn_sqrtf(__builtin_fmaf(-a, a, 1.0f)) * ig * xc;
}
constexpr int GL_TOT = 131072, GL_AGL = GL_TOT + 4096, GL_CAR = GL_AGL + 16384;
constexpr int CW_GFLAG = 8192;
__device__ __forceinline__ unsigned flag_ld(unsigned* p) { return __hip_atomic_load(p, __ATOMIC_RELAXED, __HIP_MEMORY_SCOPE_AGENT); }
struct EpiGate {
    static constexpr bool PERM = true;
    const f16* XC; const f16* GG; f16* Y; float* AGG; unsigned* FLG; float* hp; const float* br; const float* bi; const float* sp2; LAS unsigned char* lds;
    __device__ __forceinline__ void operator()(const f32x4 (&acc)[2][2][4][2], const Unit& u, int wr, int wc, int fr, int fq) const {
        const int cl = 32 * wc + 8 * fq, ch0 = 128 * u.pn + cl;
        const f16* xcp = XC + (size_t)(u.pm * 256 + wr * 64 + 4 * fr) * 1024 + ch0;
        LAS float* TOT = (LAS float*)(lds + GL_TOT);
        u32x2 hlp[2][2][4], acp[2][2][4];
        u32x2 xhi[2][4];
#pragma unroll
        for (int n = 0; n < 2; ++n) {
            float cbr[4], cbi[4], csp[4];
#pragma unroll
            for (int j = 0; j < 4; ++j) { cbr[j] = br[ch0 + 4 * n + j] * -LOG2E; cbi[j] = bi[ch0 + 4 * n + j] * -LOG2E; csp[j] = sp2[ch0 + 4 * n + j]; }
#pragma unroll
            for (int ai = 0; ai < 2; ++ai) {
                float a[4][4], b[4][4];
#pragma unroll
                for (int m = 0; m < 4; ++m) {
                    f16x4 xc;
                    if (n == 0) { const u32x4 x8 = *(const u32x4*)(xcp + (size_t)(ai * 128 + m) * 1024); xc = __builtin_bit_cast(f16x4, (u32x2){x8.x, x8.y}); xhi[ai][m] = (u32x2){x8.z, x8.w}; }
                    else xc = __builtin_bit_cast(f16x4, xhi[ai][m]);
#pragma unroll
                    for (int j = 0; j < 4; ++j) gate_ab(acc[ai][0][m][n][j], acc[ai][1][m][n][j], cbr[j], cbi[j], csp[j], (float)xc[j], a[m][j], b[m][j]);
                }
#pragma unroll
                for (int m = 1; m < 4; ++m)
#pragma unroll
                    for (int j = 0; j < 4; ++j) { b[m][j] = a[m][j] * b[m - 1][j] + b[m][j]; a[m][j] = a[m][j] * a[m - 1][j]; }
                float A[4], B[4];
#pragma unroll
                for (int j = 0; j < 4; ++j) { A[j] = a[3][j]; B[j] = b[3][j]; }
#define SCAN_STEP(CTRL, D) _Pragma("unroll") for (int j = 0; j < 4; ++j) { const float ap = dpp1<CTRL>(A[j]), bp = dppz<CTRL>(B[j]); B[j] = A[j] * bp + B[j]; A[j] = A[j] * ap; }
                SCAN_STEP(SHR1, 1) SCAN_STEP(SHR2, 2) SCAN_STEP(SHR4, 4) SCAN_STEP(SHR8, 8)
#undef SCAN_STEP
                float Ae[4], Be[4];
#pragma unroll
                for (int j = 0; j < 4; ++j) { Ae[j] = dpp1<SHR1>(A[j]); Be[j] = dppz<SHR1>(B[j]); }
#pragma unroll
                for (int m = 0; m < 4; ++m) {
                    hlp[n][ai][m] = (u32x2){pk2h(a[m][0] * Be[0] + b[m][0], a[m][1] * Be[1] + b[m][1]), pk2h(a[m][2] * Be[2] + b[m][2], a[m][3] * Be[3] + b[m][3])};
                    acp[n][ai][m] = (u32x2){pk2h(a[m][0] * Ae[0], a[m][1] * Ae[1]), pk2h(a[m][2] * Ae[2], a[m][3] * Ae[3])};
                    asm volatile("" : "+v"(hlp[n][ai][m]), "+v"(acp[n][ai][m]));
                }
                if (fr == 15) {
                    LAS float* t = TOT + ((ai * 2 + wr) * 128 + cl + 4 * n) * 2;
                    *(LAS f32x4*)t = (f32x4){A[0], B[0], A[1], B[1]}; *(LAS f32x4*)(t + 4) = (f32x4){A[2], B[2], A[3], B[3]};
                }
            }
            __builtin_amdgcn_sched_barrier(0);
        }
        asm volatile("" ::: "memory");
        int frg = fr; asm volatile("" : "+v"(frg));
        u32x4 ggv[2][4];
#pragma unroll
        for (int ai = 0; ai < 2; ++ai)
#pragma unroll
            for (int m = 0; m < 4; ++m) ggv[ai][m] = *(const u32x4*)(GG + (size_t)(u.pm * 256 + ai * 128 + wr * 64 + 4 * frg + m) * 1024 + 128 * u.pn + 32 * wc + 8 * (frg - fr + fq));
        asm volatile("s_waitcnt lgkmcnt(0)" ::: "memory"); __builtin_amdgcn_s_barrier(); asm volatile("" ::: "memory");
        const int wid = wr * 4 + wc, lane = fq * 16 + fr, tid = wid * 64 + lane, sp = u.pm & 15;
        float* aggb = AGG + (size_t)(u.pn * 64) * 256;
        unsigned* flg = FLG + u.pn * 64;
        if (wid == 0) {
#pragma unroll
            for (int hh = 0; hh < 2; ++hh) {
                const int c = lane + 64 * hh; float P = 1.f, H = 0.f;
#pragma unroll
                for (int k = 0; k < 4; ++k) { const f32x2 t = *(const LAS f32x2*)(TOT + (k * 128 + c) * 2); H = t.x * H + t.y; P *= t.x; }
                __hip_atomic_store((GAS unsigned long long*)(aggb + (size_t)u.pm * 256 + 2 * c), ((unsigned long long)__builtin_bit_cast(unsigned, H) << 32) | __builtin_bit_cast(unsigned, P), __ATOMIC_RELAXED, __HIP_MEMORY_SCOPE_AGENT);
            }
            asm volatile("s_waitcnt vmcnt(0)" ::: "memory");
            if (lane == 0) __hip_atomic_store(flg + u.pm, 1u, __ATOMIC_RELAXED, __HIP_MEMORY_SCOPE_AGENT);
            if (lane < sp) { unsigned* f = flg + u.pm - 1 - lane; unsigned spn = 0; while (flag_ld(f) == 0u) { __builtin_amdgcn_s_sleep(1); if (++spn > (1u << 20)) break; } }
            __builtin_amdgcn_fence(__ATOMIC_ACQUIRE, "agent");
            asm volatile("s_waitcnt vmcnt(0)" ::: "memory");
        }
        asm volatile("" ::: "memory"); __builtin_amdgcn_s_barrier(); asm volatile("" ::: "memory");
        {   LAS float* AGL = (LAS float*)(lds + GL_AGL);
            for (int it = tid; it < sp * 64; it += 512) { const int k = 1 + (it >> 6), q = it & 63;
                const f32x4 v = *(const f32x4*)(aggb + (size_t)(u.pm - k) * 256 + q * 4); *(LAS f32x4*)(AGL + k * 256 + q * 4) = v; }
        }
        asm volatile("s_waitcnt vmcnt(0) lgkmcnt(0)" ::: "memory"); __builtin_amdgcn_s_barrier(); asm volatile("" ::: "memory");
        if (tid < 128) {
            const LAS float* AGL = (const LAS float*)(lds + GL_AGL); LAS float* CAR = (LAS float*)(lds + GL_CAR);
            float carry = 0.f;
            for (int k = sp; k >= 1; --k) { const f32x2 t = *(const LAS f32x2*)(AGL + k * 256 + 2 * tid); carry = t.x * carry + t.y; }
#pragma unroll
            for (int k = 0; k < 4; ++k) { CAR[k * 128 + tid] = carry; const f32x2 t = *(const LAS f32x2*)(TOT + (k * 128 + tid) * 2); carry = t.x * carry + t.y; }
            if (sp == 15) hp[(size_t)(u.pm >> 4) * 1024 + 128 * u.pn + tid] = carry;
        }
        asm volatile("s_waitcnt lgkmcnt(0)" ::: "memory"); __builtin_amdgcn_s_barrier(); asm volatile("" ::: "memory");
        int fry = fr; asm volatile("" : "+v"(fry));
#pragma unroll
        for (int ai = 0; ai < 2; ++ai) {
            const LAS float* cp = (const LAS float*)(lds + GL_CAR) + (ai * 2 + wr) * 128 + cl;
            const f32x4 c0 = *(const LAS f32x4*)cp, c1 = *(const LAS f32x4*)(cp + 4);
            const f16x2 cpk[4] = {h2(c0[0], c0[1]), h2(c0[2], c0[3]), h2(c1[0], c1[1]), h2(c1[2], c1[3])};
#pragma unroll
            for (int m = 0; m < 4; ++m) {
                const int row = u.pm * 256 + ai * 128 + wr * 64 + 4 * fry + m;
                const u32x4 gw = ggv[ai][m];
                u32x4 o;
#pragma unroll
                for (int n = 0; n < 2; ++n)
#pragma unroll
                    for (int k = 0; k < 2; ++k) {
                        const unsigned h_ = hlp[n][ai][m][k], a_ = acp[n][ai][m][k], g_ = gw[2 * n + k];
                        const f16x2 hl = __builtin_bit_cast(f16x2, h_), ac = __builtin_bit_cast(f16x2, a_), gg = __builtin_bit_cast(f16x2, g_);
                        o[2 * n + k] = __builtin_bit_cast(unsigned, (hl + ac * cpk[2 * n + k]) * gg);
                    }
                *(u32x4*)(Y + (size_t)row * 1024 + 128 * u.pn + 32 * wc + 8 * (fry - fr + fq)) = o;
            }
        }
    }
};

struct EpiRes {
    static constexpr bool PERM = true;
    const float* xin;
    float* yout;
    f16* X16; float* SS; const float* bias; bool dry;
    __device__ __forceinline__ void fin(const f32x4 (&acc)[2][2][4][2], const f32x4 (&bv)[2][2], const f32x4& x0, const f32x4& x1, int ai, int bj, int m, int row, int col, float& ss) const {
        const f32x4 v0 = x0 + acc[ai][bj][m][0] + bv[bj][0], v1 = x1 + acc[ai][bj][m][1] + bv[bj][1];
        u32x4 h; h.x = pk2h(v0[0], v0[1]); h.y = pk2h(v0[2], v0[3]); h.z = pk2h(v1[0], v1[1]); h.w = pk2h(v1[2], v1[3]);
        if (!dry && !yout) *(u32x4*)(X16 + (size_t)row * 1024 + col) = h;
        if (yout) { float* y = yout + (size_t)row * 1024 + col; *(f32x4*)y = v0; *(f32x4*)(y + 4) = v1; }
        ss += ((v0[0] * v0[0] + v0[1] * v0[1]) + (v0[2] * v0[2] + v0[3] * v0[3])) + ((v1[0] * v1[0] + v1[1] * v1[1]) + (v1[2] * v1[2] + v1[3] * v1[3]));
    }
    __device__ __forceinline__ void operator()(const f32x4 (&acc)[2][2][4][2], const Unit& u, int wr, int wc, int fr, int fq) const {
        const int col0 = u.pn * 256 + wc * 32 + 8 * fq;
        f32x4 bv[2][2];
#pragma unroll
        for (int bj = 0; bj < 2; ++bj)
#pragma unroll
            for (int n = 0; n < 2; ++n) bv[bj][n] = bias ? *(const f32x4*)(bias + col0 + bj * 128 + n * 4) : (f32x4){0.f, 0.f, 0.f, 0.f};
#pragma unroll
        for (int ai = 0; ai < 2; ++ai) {
            const int rowb = u.pm * 256 + ai * 128 + wr * 64 + 4 * fr;
            if (xin) {
                f32x4 xa[4][2][2];
#pragma unroll
                for (int m = 0; m < 4; ++m)
#pragma unroll
                    for (int bj = 0; bj < 2; ++bj) { const float* p = xin + (size_t)(rowb + m) * 1024 + col0 + bj * 128; xa[m][bj][0] = *(const f32x4*)p; xa[m][bj][1] = *(const f32x4*)(p + 4); }
                asm volatile("" ::: "memory");
#pragma unroll
                for (int m = 0; m < 4; ++m) { float ss = 0.f;
#pragma unroll
                    for (int bj = 0; bj < 2; ++bj) fin(acc, bv, xa[m][bj][0], xa[m][bj][1], ai, bj, m, rowb + m, col0 + bj * 128, ss);
                    ss = sum16_32(ss);
                    if (fq == 0 && !dry && !yout) SS[(size_t)(rowb + m) * 16 + u.pn * 4 + wc] = ss; }
            } else {
                f16x8 xa[4][2];
#pragma unroll
                for (int m = 0; m < 4; ++m)
#pragma unroll
                    for (int bj = 0; bj < 2; ++bj) xa[m][bj] = *(const f16x8*)(X16 + (size_t)(rowb + m) * 1024 + col0 + bj * 128);
                asm volatile("" ::: "memory");
#pragma unroll
                for (int m = 0; m < 4; ++m) { float ss = 0.f;
#pragma unroll
                    for (int bj = 0; bj < 2; ++bj) { const f16x8 q = xa[m][bj]; const f32x4 x0 = {(float)q[0], (float)q[1], (float)q[2], (float)q[3]}, x1 = {(float)q[4], (float)q[5], (float)q[6], (float)q[7]};
                        fin(acc, bv, x0, x1, ai, bj, m, rowb + m, col0 + bj * 128, ss); }
                    ss = sum16_32(ss);
                    if (fq == 0 && !dry && !yout) SS[(size_t)(rowb + m) * 16 + u.pn * 4 + wc] = ss; }
            }
            asm volatile("" ::: "memory");
        }
    }
};

struct EpiUp {
    static constexpr bool PERM = true;
    const float* SS; f16* H; f16* GF; f16* VF; f16* GL; const float* cw; const float* cb; const float* st; float* fp; float* fs;
    __device__ __forceinline__ void operator()(const f32x4 (&acc)[2][2][4][2], const Unit& u, int wr, int wc, int fr, int fq) const {
        const int ch0 = 128 * u.pn + 32 * wc + 8 * fq;
        f16x2 w0[4], w1[4], w2[4], b0[4];
#pragma unroll
        for (int j = 0; j < 4; ++j) { w0[j] = h2(cw[ch0 + 2 * j], cw[ch0 + 2 * j + 1]); w1[j] = h2(cw[FF + ch0 + 2 * j], cw[FF + ch0 + 2 * j + 1]);
                                      w2[j] = h2(cw[2 * FF + ch0 + 2 * j], cw[2 * FF + ch0 + 2 * j + 1]); b0[j] = h2(cb[ch0 + 2 * j], cb[ch0 + 2 * j + 1]); }
#pragma unroll
        for (int ai = 0; ai < 2; ++ai) {
            const int cidx = u.pm * 4 + ai * 2 + wr, rowb = u.pm * 256 + ai * 128 + wr * 64 + 4 * fr;
            float rsa[4];
#pragma unroll
            for (int m = 0; m < 4; ++m) rsa[m] = row_rstd(SS, rowb + m, fq);
            f16x2 g[4][4], v[4][4];
#pragma unroll
            for (int m = 0; m < 4; ++m) { const f16x2 rs2 = h2(rsa[m], rsa[m]);
#pragma unroll
                for (int j = 0; j < 4; ++j) { g[m][j] = h2(acc[ai][0][m][j >> 1][2 * (j & 1)], acc[ai][0][m][j >> 1][2 * (j & 1) + 1]) * rs2;
                                              v[m][j] = h2(acc[ai][1][m][j >> 1][2 * (j & 1)], acc[ai][1][m][j >> 1][2 * (j & 1) + 1]) * rs2; } }
            u32x4 hw[4];
#pragma unroll
            for (int j = 0; j < 4; ++j) {
                const f16x2 p3 = dpph2<SHR1>(g[3][j]), p2 = dpph2<SHR1>(g[2][j]);
                const f16x2 gc[4] = {b0[j] + w0[j] * p2 + w1[j] * p3 + w2[j] * g[0][j], b0[j] + w0[j] * p3 + w1[j] * g[0][j] + w2[j] * g[1][j],
                                     b0[j] + w0[j] * g[0][j] + w1[j] * g[1][j] + w2[j] * g[2][j], b0[j] + w0[j] * g[1][j] + w1[j] * g[2][j] + w2[j] * g[3][j]};
                f16x2 ge[4]; gelu4_h2(gc, ge);
#pragma unroll
                for (int m = 0; m < 4; ++m) hw[m][j] = __builtin_bit_cast(unsigned, ge[m] * v[m][j]);
            }
#pragma unroll
            for (int m = 0; m < 4; ++m) {
                *(u32x4*)(H + (size_t)(rowb + m) * FF + ch0) = hw[m];
#define GR_ (u32x4){__builtin_bit_cast(unsigned, g[m][0]), __builtin_bit_cast(unsigned, g[m][1]), __builtin_bit_cast(unsigned, g[m][2]), __builtin_bit_cast(unsigned, g[m][3])}
                if (m < 2 && fr == 0) {
                    *(u32x4*)(GF + ((size_t)cidx * 2 + m) * FF + ch0) = GR_;
                    *(u32x4*)(VF + ((size_t)cidx * 2 + m) * FF + ch0) = (u32x4){__builtin_bit_cast(unsigned, v[m][0]), __builtin_bit_cast(unsigned, v[m][1]), __builtin_bit_cast(unsigned, v[m][2]), __builtin_bit_cast(unsigned, v[m][3])};
                }
                if (m >= 2 && fr == 15) {
                    *(u32x4*)(GL + ((size_t)cidx * 2 + (m - 2)) * FF + ch0) = GR_;
                    const int t = (rowb + m) & 4095;
                    if (t >= 4094) { float* dst = fp + ((size_t)((rowb + m) >> 12) * 2 + (t - 4094)) * FF + ch0;
                        *(f32x4*)dst = acc[ai][0][m][0] * rsa[m]; *(f32x4*)(dst + 4) = acc[ai][0][m][1] * rsa[m]; }
                }
#undef GR_
            }
        }
    }
};

struct EpiKV {
    static constexpr bool PERM = true;
    const float* SS; const float* bkv; const float* knorm; f16* K16; f16* V16; f16* KS16; f16* VS16; float* out;
    __device__ __forceinline__ void operator()(ACC_T, const Unit& u, int wr, int wc, int fr, int fq) const {
        const bool isv = u.pn == 1;
        f32x4 bv[2][2], gn[2][2];
#pragma unroll
        for (int bj = 0; bj < 2; ++bj)
#pragma unroll
            for (int n = 0; n < 2; ++n) { const int d = 32 * bj + 8 * fq + 4 * n; bv[bj][n] = *(const f32x4*)(bkv + u.pn * 256 + 64 * wc + d); gn[bj][n] = *(const f32x4*)(knorm + d); }
        float rsa[2][4];
#pragma unroll
        for (int ai = 0; ai < 2; ++ai)
#pragma unroll
            for (int m = 0; m < 4; ++m) rsa[ai][m] = row_rstd(SS, u.pm * 256 + ai * 128 + wr * 64 + 4 * fr + m, fq);
#pragma unroll
        for (int ai = 0; ai < 2; ++ai)
#pragma unroll
            for (int m = 0; m < 4; ++m) {
                const int row = u.pm * 256 + ai * 128 + wr * 64 + 4 * fr + m;
                const float rs = rsa[ai][m];
                f32x4 v[2][2]; float ss = 0.f;
#pragma unroll
                for (int bj = 0; bj < 2; ++bj)
#pragma unroll
                    for (int n = 0; n < 2; ++n) { v[bj][n] = acc[ai][bj][m][n] * rs + bv[bj][n]; const f32x4 q = v[bj][n]; ss += (q[0] * q[0] + q[1] * q[1]) + (q[2] * q[2] + q[3] * q[3]); }
                ss = sum16_32(ss);
                const float ri = __builtin_amdgcn_rsqf(ss * (1.0f / 64.0f) + EPS);
                f16* d16 = (isv ? V16 : K16) + (size_t)row * 256 + 64 * wc; float* d32 = nullptr;
                { const int t = row & 4095; if (t >= 3968) d32 = out + (isv ? O_VP : O_KP) + ((size_t)(row >> 12) * 128 + (t - 3968)) * 256 + 64 * wc; }
#pragma unroll
                for (int bj = 0; bj < 2; ++bj) {
                    const int d = 32 * bj + 8 * fq;
                    f32x4 o0 = v[bj][0], o1 = v[bj][1]; if (!isv) { o0 = o0 * ri * gn[bj][0]; o1 = o1 * ri * gn[bj][1]; }
                    u32x4 h; h.x = pk2h(o0[0], o0[1]); h.y = pk2h(o0[2], o0[3]); h.z = pk2h(o1[0], o1[1]); h.w = pk2h(o1[2], o1[3]);
                    *(u32x4*)(d16 + d) = h;
                    if (d32) { *(f32x4*)(d32 + d) = o0; *(f32x4*)(d32 + d + 4) = o1; }
                }
            }
    }
};

struct EpiQ {
    static constexpr bool PERM = true;
    const float* SS; const float* bq; const float* qnorm; f16* Q16;
    __device__ __forceinline__ void operator()(ACC_T, const Unit& u, int wr, int wc, int fr, int fq) const {
        f32x4 bv[2][2], gn[2][2];
        const int hc = u.pn * 256 + 64 * wc;
#pragma unroll
        for (int bj = 0; bj < 2; ++bj)
#pragma unroll
            for (int n = 0; n < 2; ++n) { const int d = 32 * bj + 8 * fq + 4 * n; bv[bj][n] = *(const f32x4*)(bq + hc + d); gn[bj][n] = *(const f32x4*)(qnorm + d) * QSCALE; }
        float rsa[2][4];
#pragma unroll
        for (int ai = 0; ai < 2; ++ai)
#pragma unroll
            for (int m = 0; m < 4; ++m) rsa[ai][m] = row_rstd(SS, u.pm * 256 + ai * 128 + wr * 64 + 4 * fr + m, fq);
#pragma unroll
        for (int ai = 0; ai < 2; ++ai)
#pragma unroll
            for (int m = 0; m < 4; ++m) {
                const int row = u.pm * 256 + ai * 128 + wr * 64 + 4 * fr + m;
                const float rs = rsa[ai][m];
                f32x4 v[2][2]; float ss = 0.f;
#pragma unroll
                for (int bj = 0; bj < 2; ++bj)
#pragma unroll
                    for (int n = 0; n < 2; ++n) { v[bj][n] = acc[ai][bj][m][n] * rs + bv[bj][n]; const f32x4 q = v[bj][n]; ss += (q[0] * q[0] + q[1] * q[1]) + (q[2] * q[2] + q[3] * q[3]); }
                ss = sum16_32(ss);
                const float ri = __builtin_amdgcn_rsqf(ss * (1.0f / 64.0f) + EPS);
#pragma unroll
                for (int bj = 0; bj < 2; ++bj) {
                    const int d = 32 * bj + 8 * fq;
                    const f32x4 o0 = v[bj][0] * ri * gn[bj][0], o1 = v[bj][1] * ri * gn[bj][1];
                    u32x4 h; h.x = pk2h(o0[0], o0[1]); h.y = pk2h(o0[2], o0[3]); h.z = pk2h(o1[0], o1[1]); h.w = pk2h(o1[2], o1[3]);
                    *(u32x4*)(Q16 + (size_t)row * 1024 + hc + d) = h;
                }
            }
    }
};
#undef ACC_T


__device__ __forceinline__ float rstd_row(const float* SS, int row) {
    const f32x4* p = (const f32x4*)(SS + (size_t)row * 16);
    const f32x4 a = p[0], b = p[1], c = p[2], d = p[3];
    const float t = ((a.x + a.y) + (a.z + a.w)) + ((b.x + b.y) + (b.z + b.w)) + ((c.x + c.y) + (c.z + c.w)) + ((d.x + d.y) + (d.z + d.w));
    return __builtin_amdgcn_rsqf(t * (1.0f / 1024.0f) + EPS);
}
namespace sg {
constexpr int TST = 68;
constexpr int PT_BYTES = 64 * TST * 4;
struct SGemm { const f16* A; int lda; const f16* Bt; int K; };
template <class EPI>
__device__ __forceinline__ void stile_finish(LAS unsigned char* lds, const f32x4 (&acc)[4][4], const EPI& E, int rt, int ct, int wave) {
    int z_ = 0; asm volatile("" : "+v"(z_));
    const int lane_ = (int)__builtin_amdgcn_mbcnt_hi(~0u, __builtin_amdgcn_mbcnt_lo(~0u, (unsigned)z_)), tid = wave * 64 + lane_, fr = lane_ & 15, fq = lane_ >> 4;
    LAS float* P = (LAS float*)(lds + wave * PT_BYTES);
#pragma unroll
    for (int mb = 0; mb < 4; ++mb)
#pragma unroll
        for (int nb = 0; nb < 4; ++nb) *(LAS f32x4*)(P + (16 * mb + fr) * TST + 16 * nb + 4 * fq) = acc[mb][nb];
    __syncthreads();
    {   const int r = tid >> 3, c8 = (tid & 7) * 8;
        LAS float* T0 = (LAS float*)lds + r * TST + c8;
        f32x4 s0 = *(LAS f32x4*)T0, s1 = *(LAS f32x4*)(T0 + 4);
#pragma unroll
        for (int w = 1; w < 8; ++w) { const LAS float* Tw = (const LAS float*)(lds + w * PT_BYTES) + r * TST + c8; s0 += *(const LAS f32x4*)Tw; s1 += *(const LAS f32x4*)(Tw + 4); }
        if constexpr (EPI::ROWSCALE) { const float rs = rstd_row(E.SS, MP + 64 * rt + r); s0 = s0 * rs; s1 = s1 * rs; }
        *(LAS f32x4*)T0 = s0; *(LAS f32x4*)(T0 + 4) = s1;
    }
    __syncthreads();
    E.tile((LAS float*)lds, rt, ct, tid);
    __syncthreads();
}
template <int NSTEP, class EPI>
__device__ __forceinline__ void sgemm_phase(LAS unsigned char* lds, const SGemm g, const int nct, const EPI& E, const int vcu, const int G, const int tid) {
    const int lane = tid & 63, wave = __builtin_amdgcn_readfirstlane(tid >> 6), fr = lane & 15, fq = lane >> 4;
    constexpr int kw = NSTEP * 32;
    const int nunits = 16 * nct;
    if constexpr (NSTEP == 4) {
        int su = vcu; if (su >= nunits) return;
        f16x8 af[4][4], bf[4][4]; int rt_have = -1;
        {   const int ct = su >> 4;
#pragma unroll
            for (int nb = 0; nb < 4; ++nb) { const f16* Bb = g.Bt + (size_t)(E.brow(ct, nb) + fr) * g.K + wave * kw + 8 * fq;
#pragma unroll
                for (int s = 0; s < 4; ++s) bf[s][nb] = *(const f16x8*)(Bb + 32 * s); } }
        for (; su < nunits; su += G) {
            const int rt = su & 15, ct = su >> 4;
            if (rt != rt_have) { rt_have = rt; const f16* Ab = g.A + (size_t)(MP + 64 * rt + fr) * g.lda + E.acol(ct) + wave * kw + 8 * fq;
#pragma unroll
                for (int mb = 0; mb < 4; ++mb)
#pragma unroll
                    for (int s = 0; s < 4; ++s) af[s][mb] = *(const f16x8*)(Ab + (size_t)mb * 16 * g.lda + 32 * s); }
            f32x4 acc[4][4];
#pragma unroll
            for (int a = 0; a < 4; ++a)
#pragma unroll
                for (int b = 0; b < 4; ++b) acc[a][b] = (f32x4){0.f, 0.f, 0.f, 0.f};
#pragma unroll
            for (int s = 0; s < 4; ++s)
#pragma unroll
                for (int mb = 0; mb < 4; ++mb)
#pragma unroll
                    for (int nb = 0; nb < 4; ++nb) acc[mb][nb] = __builtin_amdgcn_mfma_f32_16x16x32_f16(bf[s][nb], af[s][mb], acc[mb][nb], 0, 0, 0);
            if (su + G < nunits) { const int ctn = (su + G) >> 4;
#pragma unroll
                for (int nb = 0; nb < 4; ++nb) { const f16* Bb = g.Bt + (size_t)(E.brow(ctn, nb) + fr) * g.K + wave * kw + 8 * fq;
#pragma unroll
                    for (int s = 0; s < 4; ++s) bf[s][nb] = *(const f16x8*)(Bb + 32 * s); } }
            stile_finish(lds, acc, E, rt, ct, wave);
        }
    } else {
        constexpr int CH = NSTEP >= 2 ? 2 : 1, NCH = NSTEP / CH;
        for (int su = vcu; su < nunits; su += G) {
            const int rt = su & 15, ct = su >> 4;
            f32x4 acc[4][4];
#pragma unroll
            for (int a = 0; a < 4; ++a)
#pragma unroll
                for (int b = 0; b < 4; ++b) acc[a][b] = (f32x4){0.f, 0.f, 0.f, 0.f};
            const f16* Ab = g.A + (size_t)(MP + 64 * rt + fr) * g.lda + E.acol(ct) + wave * kw + 8 * fq;
            const f16* Bb[4];
#pragma unroll
            for (int nb = 0; nb < 4; ++nb) Bb[nb] = g.Bt + (size_t)(E.brow(ct, nb) + fr) * g.K + wave * kw + 8 * fq;
            f16x8 a0[CH][4], b0[CH][4], a1[CH][4], b1[CH][4];
#define SG_LOAD(A_, B_, c) do { _Pragma("unroll") for (int s = 0; s < CH; ++s) { _Pragma("unroll") for (int mb = 0; mb < 4; ++mb) A_[s][mb] = *(const f16x8*)(Ab + (size_t)mb * 16 * g.lda + 32 * ((c) * CH + s)); \
                _Pragma("unroll") for (int nb = 0; nb < 4; ++nb) B_[s][nb] = *(const f16x8*)(Bb[nb] + 32 * ((c) * CH + s)); } } while (0)
#define SG_MMA(A_, B_) do { _Pragma("unroll") for (int s = 0; s < CH; ++s) _Pragma("unroll") for (int mb = 0; mb < 4; ++mb) _Pragma("unroll") for (int nb = 0; nb < 4; ++nb) \
                acc[mb][nb] = __builtin_amdgcn_mfma_f32_16x16x32_f16(B_[s][nb], A_[s][mb], acc[mb][nb], 0, 0, 0); } while (0)
            SG_LOAD(a0, b0, 0);
            if constexpr (NCH == 1) { SG_MMA(a0, b0); }
            else {
#pragma unroll 1
                for (int c = 0; c < NCH; c += 2) {
                    SG_LOAD(a1, b1, c + 1);
                    SG_MMA(a0, b0);
                    if (c + 2 < NCH) SG_LOAD(a0, b0, c + 2);
                    SG_MMA(a1, b1);
                }
            }
#undef SG_LOAD
#undef SG_MMA
            stile_finish(lds, acc, E, rt, ct, wave);
        }
    }
}
template <class EPI>
__device__ __forceinline__ void sgemm_staged(LAS unsigned char* lds, const SGemm g, const int nct, const EPI& E, const int vcu, const int G, const int tid) {
    const int lane = tid & 63, wave = __builtin_amdgcn_readfirstlane(tid >> 6), fr = lane & 15, fq = lane >> 4;
    const int nunits = 16 * nct, nch = g.K >> 8;
    int R, C; pg8::stage_rc(tid * 16, R, C);
    const unsigned ldsw = (unsigned)wave * 1024u;
    const int rdoff = (wave >> 1) * 8192 + pg8::lds_byte(fr, 32 * (wave & 1) + 8 * fq);
    for (int su = vcu; su < nunits; su += G) {
        const int rt = su & 15, ct = su >> 4;
        const char* Ap = (const char*)(g.A + (size_t)(MP + 64 * rt + R) * g.lda + E.acol(ct) + C);
        const char* Bp = (const char*)(g.Bt + (size_t)(E.brow(ct, R >> 4) + (R & 15)) * g.K + C);
#define SGS_STAGE(buf, kc) do { _Pragma("unroll") for (int s_ = 0; s_ < 4; ++s_) { \
            __builtin_amdgcn_global_load_lds((const unsigned*)(Ap + (size_t)(kc) * 512 + s_ * 128), (LAS unsigned*)(lds + (buf) * 65536 + s_ * 8192 + ldsw), 16, 0, 0); \
            __builtin_amdgcn_global_load_lds((const unsigned*)(Bp + (size_t)(kc) * 512 + s_ * 128), (LAS unsigned*)(lds + (buf) * 65536 + 32768 + s_ * 8192 + ldsw), 16, 0, 0); } } while (0)
        f32x4 acc[4][4];
#pragma unroll
        for (int a = 0; a < 4; ++a)
#pragma unroll
            for (int b = 0; b < 4; ++b) acc[a][b] = (f32x4){0.f, 0.f, 0.f, 0.f};
        SGS_STAGE(0, 0); if (nch > 1) SGS_STAGE(1, 1);
#pragma unroll 1
        for (int kc = 0; kc < nch; ++kc) {
            const int buf = kc & 1;
            if (kc + 1 < nch) asm volatile("s_waitcnt vmcnt(8)" ::: "memory"); else asm volatile("s_waitcnt vmcnt(0)" ::: "memory");
            __builtin_amdgcn_s_barrier(); asm volatile("" ::: "memory");
            f16x8 af[4], bf[4];
#pragma unroll
            for (int mb = 0; mb < 4; ++mb) af[mb] = *(const LAS f16x8*)(lds + buf * 65536 + rdoff + mb * 2048);
#pragma unroll
            for (int nb = 0; nb < 4; ++nb) bf[nb] = *(const LAS f16x8*)(lds + buf * 65536 + 32768 + rdoff + nb * 2048);
            asm volatile("s_waitcnt lgkmcnt(0)" ::: "memory");
            __builtin_amdgcn_s_barrier(); asm volatile("" ::: "memory");
            if (kc + 2 < nch) SGS_STAGE(buf, kc + 2);
            __builtin_amdgcn_sched_barrier(0);
#pragma unroll
            for (int mb = 0; mb < 4; ++mb)
#pragma unroll
                for (int nb = 0; nb < 4; ++nb) acc[mb][nb] = __builtin_amdgcn_mfma_f32_16x16x32_f16(bf[nb], af[mb], acc[mb][nb], 0, 0, 0);
        }
#undef SGS_STAGE
        stile_finish(lds, acc, E, rt, ct, wave);
    }
}
}

#define STILE(r, c) T[(r) * sg::TST + (c)]
struct SEpiIn {
    static constexpr bool ROWSCALE = true;
    const float* SS; f16* GG; f16* XC; const float* cw; const float* cb; const float* st  ; float* conv_s;
    __device__ __forceinline__ int acol(int) const { return 0; }
    __device__ __forceinline__ int brow(int ct, int nb) const { return 64 * ct + 16 * nb; }
    __device__ __forceinline__ void tile(LAS float* T, int rt, int ct, int tid) const {
        const int r = tid >> 3, c8 = (tid & 7) * 8, row = MP + 64 * rt + r;
        float v[8];
#pragma unroll
        for (int i = 0; i < 8; ++i) v[i] = STILE(r, c8 + i);
        if (ct < 16) {
#pragma unroll
            for (int i = 0; i < 8; ++i) v[i] = gelu_t(v[i]);
            st8(GG + (size_t)row * 1024 + 64 * ct + c8, v);
        } else {
            const int col = 64 * (ct - 16) + c8, t = row & 7, db = (row - MP) >> 3;
            float o[8];
#pragma unroll
            for (int i = 0; i < 8; ++i) {
                float acc_ = cb[col + i] + cw[3072 + col + i] * v[i];
#pragma unroll
                for (int k = 1; k <= 3; ++k) { const float xk = t >= k ? STILE(t >= k ? r - k : r, c8 + i) : st[((size_t)db * 3 + (3 + t - k)) * 1024 + col + i]; acc_ += cw[(3 - k) * 1024 + col + i] * xk; }
                o[i] = acc_;
            }
            st8(XC + (size_t)row * 1024 + col, o);
            if (t >= 5) { float* dst = conv_s + ((size_t)db * 3 + (t - 5)) * 1024 + col; *(f32x4*)dst = (f32x4){v[0], v[1], v[2], v[3]}; *(f32x4*)(dst + 4) = (f32x4){v[4], v[5], v[6], v[7]}; }
        }
    }
};
struct SEpiGate {
    static constexpr bool ROWSCALE = false; const float* SS = nullptr;
    const f16* XC; const f16* GG; f16* Y; const float* hst  ; float* hs  ; const float* br; const float* bi; const float* sp2;
    __device__ __forceinline__ int acol(int ct) const { return (ct >> 3) * 256; }
    __device__ __forceinline__ int brow(int ct, int nb) const { return 256 * (ct >> 2) + 32 * (ct & 3) + 16 * (nb & 1) + 128 * (nb >> 1); }
    __device__ __forceinline__ void tile(LAS float* T, int rt, int ct, int tid) const {
        const int r = tid >> 3, c4 = (tid & 7) * 4, row = MP + 64 * rt + r, ch = 32 * ct + c4;
        const f16x4 xc = *(const f16x4*)(XC + (size_t)row * 1024 + ch);
#pragma unroll
        for (int j = 0; j < 4; ++j) { float a, b; gate_ab(STILE(r, c4 + j), STILE(r, 32 + c4 + j), br[ch + j] * -LOG2E, bi[ch + j] * -LOG2E, sp2[ch + j], (float)xc[j], a, b); STILE(r, c4 + j) = a; STILE(r, 32 + c4 + j) = b; }
        __syncthreads();
        const int t = r & 7, db = (row - MP) >> 3;
        const f32x4 h0 = *(const f32x4*)(hst + (size_t)db * 1024 + ch);
        const f16x4 gg = *(const f16x4*)(GG + (size_t)row * 1024 + ch);
        float y[4], hf[4];
#pragma unroll
        for (int j = 0; j < 4; ++j) { float h = h0[j];
            for (int s = 0; s <= t; ++s) { const float a = STILE(r - t + s, c4 + j), b = STILE(r - t + s, 32 + c4 + j); h = a * h + b; }
            hf[j] = h; y[j] = (float)gg[j] * h; }
        u32x2 x; x.x = pk2h(y[0], y[1]); x.y = pk2h(y[2], y[3]); *(u32x2*)(Y + (size_t)row * 1024 + ch) = x;
        if (t == 7) *(f32x4*)(hs + (size_t)db * 1024 + ch) = (f32x4){hf[0], hf[1], hf[2], hf[3]};
    }
};
struct SEpiRes {
    static constexpr bool ROWSCALE = false;
    const float* xin;
    float* yout;
    f16* X16; float* SS; const float* bias; bool dry;
    __device__ __forceinline__ int acol(int) const { return 0; }
    __device__ __forceinline__ int brow(int ct, int nb) const { return 64 * ct + 16 * nb; }
    __device__ __forceinline__ void tile(LAS float* T, int rt, int ct, int tid) const {
        const int r = tid >> 3, c8 = (tid & 7) * 8, row = MP + 64 * rt + r, col = 64 * ct + c8;
        float x[8];
        if (xin) { const float* xo = xin + (size_t)(row - MP) * 1024 + col; const f32x4 x0 = *(const f32x4*)xo, x1 = *(const f32x4*)(xo + 4);
#pragma unroll
            for (int i = 0; i < 4; ++i) { x[i] = x0[i]; x[4 + i] = x1[i]; } }
        else ld8(X16 + (size_t)row * 1024 + col, x);
        float v[8]; float ss = 0.f;
#pragma unroll
        for (int i = 0; i < 8; ++i) { v[i] = STILE(r, c8 + i) + x[i] + (bias ? bias[col + i] : 0.f); ss += v[i] * v[i]; }
        if (yout) { float* xd = yout + (size_t)(row - MP) * 1024 + col; *(f32x4*)xd = (f32x4){v[0], v[1], v[2], v[3]}; *(f32x4*)(xd + 4) = (f32x4){v[4], v[5], v[6], v[7]}; }
        ss = sum8(ss);
        if (!dry && !yout) { st8(X16 + (size_t)row * 1024 + col, v); if ((tid & 7) == 0) SS[(size_t)row * 16 + ct] = ss; }
    }
};
struct SEpiUp {
    static constexpr bool ROWSCALE = true;
    const float* SS; f16* H; const float* cw; const float* cb; const float* st; float* fs;
    __device__ __forceinline__ int acol(int) const { return 0; }
    __device__ __forceinline__ int brow(int ct, int nb) const { return 256 * (ct >> 2) + 32 * (ct & 3) + 16 * (nb & 1) + 128 * (nb >> 1); }
    __device__ __forceinline__ void tile(LAS float* T, int rt, int ct, int tid) const {
        const int r = tid >> 3, c4 = (tid & 7) * 4, row = MP + 64 * rt + r, t = r & 7, db = (64 * rt + r) >> 3, ch = 128 * (ct >> 2) + 32 * (ct & 3) + c4;
        float h[4], g0[4];
#pragma unroll
        for (int j = 0; j < 4; ++j) {
            g0[j] = STILE(r, c4 + j); const float vv = STILE(r, 32 + c4 + j);
            const float s1 = st[((size_t)db * 2 + 1) * FF + ch + j], s0 = st[((size_t)db * 2) * FF + ch + j];
            const float gm1 = t >= 1 ? STILE(t >= 1 ? r - 1 : r, c4 + j) : s1;
            const float gm2 = t >= 2 ? STILE(t >= 2 ? r - 2 : r, c4 + j) : (t == 1 ? s1 : s0);
            const float gc = cb[ch + j] + cw[ch + j] * gm2 + cw[FF + ch + j] * gm1 + cw[2 * FF + ch + j] * g0[j];
            h[j] = gelu_t(gc) * vv;
        }
        u32x2 a; a.x = pk2h(h[0], h[1]); a.y = pk2h(h[2], h[3]); *(u32x2*)(H + (size_t)row * FF + ch) = a;
        if (t >= 6) *(f32x4*)(fs + ((size_t)db * 2 + (t - 6)) * FF + ch) = (f32x4){g0[0], g0[1], g0[2], g0[3]};
    }
};
struct SEpiKV {
    static constexpr bool ROWSCALE = true;
    const float* SS; const float* bkv; const float* knorm; f16* KS16; f16* VS16; float* out;
    __device__ __forceinline__ int acol(int) const { return 0; }
    __device__ __forceinline__ int brow(int ct, int nb) const { return 256 * (ct >> 2) + 128 * (nb >> 1) + 32 * (ct & 3) + 16 * (nb & 1); }
    __device__ __forceinline__ void tile(LAS float* T, int rt, int ct, int tid) const {
        const int r = tid >> 3, c8 = (tid & 7) * 8, row = MP + 64 * rt + r; const bool isv = ct >= 4; const int hd = ct & 3;
        float v[8]; float ss = 0.f;
#pragma unroll
        for (int i = 0; i < 8; ++i) { v[i] = STILE(r, c8 + i) + bkv[64 * ct + c8 + i]; ss += v[i] * v[i]; }
        ss = sum8(ss);
        if (!isv) { const float ri = __builtin_amdgcn_rsqf(ss * (1.0f / 64.0f) + EPS);
#pragma unroll
            for (int i = 0; i < 8; ++i) v[i] = v[i] * ri * knorm[c8 + i]; }
        const int db = (row - MP) >> 3, t = row & 7;
        st8((isv ? VS16 : KS16) + ((size_t)db * 160 + 128 + t) * 256 + 64 * hd + c8, v);
        float* d32 = out + (isv ? O_VS : O_KS) + ((size_t)db * 128 + 120 + t) * 256 + 64 * hd + c8;
        *(f32x4*)d32 = (f32x4){v[0], v[1], v[2], v[3]}; *(f32x4*)(d32 + 4) = (f32x4){v[4], v[5], v[6], v[7]};
    }
};
struct SEpiQ {
    static constexpr bool ROWSCALE = true;
    const float* SS; const float* bq; const float* qnorm; f16* Q16;
    __device__ __forceinline__ int acol(int) const { return 0; }
    __device__ __forceinline__ int brow(int ct, int nb) const { return 256 * (ct >> 2) + 128 * (nb >> 1) + 32 * (ct & 3) + 16 * (nb & 1); }
    __device__ __forceinline__ void tile(LAS float* T, int rt, int ct, int tid) const {
        const int r = tid >> 3, c8 = (tid & 7) * 8, row = MP + 64 * rt + r;
        float v[8]; float ss = 0.f;
#pragma unroll
        for (int i = 0; i < 8; ++i) { v[i] = STILE(r, c8 + i) + bq[64 * ct + c8 + i]; ss += v[i] * v[i]; }
        ss = sum8(ss);
        const float ri = __builtin_amdgcn_rsqf(ss * (1.0f / 64.0f) + EPS) * QSCALE;
#pragma unroll
        for (int i = 0; i < 8; ++i) v[i] = v[i] * ri * qnorm[c8 + i];
        st8(Q16 + (size_t)row * 1024 + 64 * ct + c8, v);
    }
};
#undef STILE

struct EpiNull {
    static constexpr bool PERM = true; float* sink;
    __device__ __forceinline__ void operator()(const f32x4 (&acc)[2][2][4][2], const Unit& u, int wr, int wc, int fr, int fq) const {
        float s = 0.f;
#pragma unroll
        for (int ai = 0; ai < 2; ++ai)
#pragma unroll
            for (int bj = 0; bj < 2; ++bj)
#pragma unroll
                for (int m = 0; m < 4; ++m)
#pragma unroll
                    for (int n = 0; n < 2; ++n) s += (acc[ai][bj][m][n][0] + acc[ai][bj][m][n][1]) + (acc[ai][bj][m][n][2] + acc[ai][bj][m][n][3]);
        if (s == 123.456f) sink[fr] = s;
    }
};
struct EpiKVQ {
    static constexpr bool PERM = true; EpiKV kv; EpiQ q;
    __device__ __forceinline__ void operator()(const f32x4 (&acc)[2][2][4][2], const Unit& u, int wr, int wc, int fr, int fq) const {
        if (u.pn < 2) kv(acc, u, wr, wc, fr, fq); else { const Unit u2{u.pm, u.pn - 2}; q(acc, u2, wr, wc, fr, fq); }
    }
};
struct SEpiKVQ {
    static constexpr bool ROWSCALE = true; SEpiKV kv; SEpiQ q; const float* SS;
    __device__ __forceinline__ int acol(int) const { return 0; }
    __device__ __forceinline__ int brow(int ct, int nb) const { return 256 * (ct >> 2) + 128 * (nb >> 1) + 32 * (ct & 3) + 16 * (nb & 1); }
    __device__ __forceinline__ void tile(LAS float* T, int rt, int ct, int tid) const { if (ct < 8) kv.tile(T, rt, ct, tid); else q.tile(T, rt, ct - 8, tid); }
};

__device__ __forceinline__ void sup_phase(LAS unsigned char* lds, const f16* X16, const f16* Wt, const float* SS, f16* H, const float* cw, const float* cb, const float* st, float* fs,
                                          const int vcu, const int G, const int tid) {
    if (vcu >= 8 * 24) return;
    const int lane = tid & 63, wave = __builtin_amdgcn_readfirstlane(tid >> 6), fr = lane & 15, fq = lane >> 4;
    constexpr int SA = 0, SB = 49152, SBUF_A = 16384, SBUF_B = 32768;
    unsigned voffA[2], voffB[4];
    { int R, C;
#pragma unroll
      for (int i = 0; i < 2; ++i) { pg8::stage_rc(tid * 16 + i * 8192, R, C); voffA[i] = (unsigned)(R * 1024 + C) * 2u; }
#pragma unroll
      for (int p = 0; p < 4; ++p) { pg8::stage_rc(tid * 16 + (p & 1) * 8192, R, C); const int rho = 128 * (p >> 1) + R;
          voffB[p] = (unsigned)((128 * ((rho >> 4) & 1) + 16 * (rho >> 5) + (rho & 15)) * 1024 + C) * 2u; } }
    const unsigned ldsw = (unsigned)wave * 1024u;
    const int aoff = pg8::lds_byte(fr, fq * 8), boff = (wave >> 2) * 16384 + pg8::lds_byte((wave & 3) * 32 + fr, fq * 8);
#define SUP_STAGE(buf, kc) do { \
        _Pragma("unroll") for (int i_ = 0; i_ < 2; ++i_) __builtin_amdgcn_global_load_lds((const unsigned*)(Ag + voffA[i_] + (size_t)(kc) * 128), (LAS unsigned*)(lds + SA + (buf) * SBUF_A + i_ * 8192 + ldsw), 16, 0, 0); \
        _Pragma("unroll") for (int p_ = 0; p_ < 4; ++p_) __builtin_amdgcn_global_load_lds((const unsigned*)(Bgp + voffB[p_] + (size_t)(kc) * 128), (LAS unsigned*)(lds + SB + (buf) * SBUF_B + p_ * 8192 + ldsw), 16, 0, 0); } while (0)
    for (int su = vcu; su < 8 * 24; su += G) {
        const int rt = su & 7, ct = su >> 3;
        const char* Ag = (const char*)(X16 + (size_t)(MP + 128 * rt) * 1024); const char* Bgp = (const char*)(Wt + (size_t)(256 * ct) * 1024);
        const int c0 = 128 * ct + 16 * wave + 4 * fq, t = fr & 7;
        float rs[8];
#pragma unroll
        for (int mb = 0; mb < 8; ++mb) rs[mb] = row_rstd(SS, MP + 128 * rt + 16 * mb + fr, fq);
        const f32x4 w0 = *(const f32x4*)(cw + c0), w1 = *(const f32x4*)(cw + FF + c0), w2 = *(const f32x4*)(cw + 2 * FF + c0), b0 = *(const f32x4*)(cb + c0);
        asm volatile("s_waitcnt vmcnt(0)" ::: "memory");
        f32x4 acc[2][8];
#pragma unroll
        for (int a = 0; a < 2; ++a)
#pragma unroll
            for (int b = 0; b < 8; ++b) acc[a][b] = (f32x4){0.f, 0.f, 0.f, 0.f};
        SUP_STAGE(0, 0); SUP_STAGE(1, 1);
        int buf = 0;
#pragma unroll 1
        for (int kc = 0; kc < 16; ++kc) {
            if (kc + 1 < 16) asm volatile("s_waitcnt vmcnt(6)" ::: "memory"); else asm volatile("s_waitcnt vmcnt(0)" ::: "memory");
            __builtin_amdgcn_s_barrier(); asm volatile("" ::: "memory");
            if (kc + 2 < 16) { const int b2 = buf == 0 ? 2 : buf - 1; SUP_STAGE(b2, kc + 2); }
            f16x8 bf[2][2];
#pragma unroll
            for (int n = 0; n < 2; ++n)
#pragma unroll
                for (int k = 0; k < 2; ++k) bf[n][k] = *(const LAS f16x8*)(lds + SB + buf * SBUF_B + boff + n * 2048 + k * 1024);
#pragma unroll
            for (int hm = 0; hm < 2; ++hm) {
                f16x8 af[4][2];
#pragma unroll
                for (int mb = 0; mb < 4; ++mb)
#pragma unroll
                    for (int k = 0; k < 2; ++k) af[mb][k] = *(const LAS f16x8*)(lds + SA + buf * SBUF_A + aoff + (4 * hm + mb) * 2048 + k * 1024);
                asm volatile("s_waitcnt lgkmcnt(0)" ::: "memory");
                __builtin_amdgcn_sched_barrier(0);
#pragma unroll
                for (int mb = 0; mb < 4; ++mb)
#pragma unroll
                    for (int n = 0; n < 2; ++n)
#pragma unroll
                        for (int k = 0; k < 2; ++k) acc[n][4 * hm + mb] = __builtin_amdgcn_mfma_f32_16x16x32_f16(bf[n][k], af[mb][k], acc[n][4 * hm + mb], 0, 0, 0);
                __builtin_amdgcn_sched_barrier(0);
            }
            buf = buf == 2 ? 0 : buf + 1;
        }
        __builtin_amdgcn_s_barrier(); asm volatile("" ::: "memory");
        f32x4 s1a[8], s0a[8];
#pragma unroll
        for (int mb = 0; mb < 8; ++mb) { const int db = (128 * rt + 16 * mb + fr) >> 3; const int tt = t < 2 ? 1 : 0;
            s1a[mb] = *(const f32x4*)(st + ((size_t)db * 2 + tt) * FF + c0); s0a[mb] = *(const f32x4*)(st + ((size_t)db * 2) * FF + c0); }
#pragma unroll
        for (int mb = 0; mb < 8; ++mb) {
            const int rl = 128 * rt + 16 * mb + fr, db = rl >> 3; const size_t row = (size_t)MP + rl;
            const f32x4 g = acc[0][mb] * rs[mb], v = acc[1][mb] * rs[mb];
            const f32x4 s1 = s1a[mb], s0 = s0a[mb];
            float h[4];
#pragma unroll
            for (int j = 0; j < 4; ++j) {
                const float p1 = dppz<SHR1>(g[j]), p2 = dppz<SHR2>(g[j]);
                const float gm1 = t >= 1 ? p1 : s1[j], gm2 = t >= 2 ? p2 : (t == 1 ? s1[j] : s0[j]);
                const float gc = b0[j] + w0[j] * gm2 + w1[j] * gm1 + w2[j] * g[j];
                h[j] = gelu_t(gc) * v[j];
            }
            u32x2 o; o.x = pk2h(h[0], h[1]); o.y = pk2h(h[2], h[3]);
            *(u32x2*)(H + row * FF + c0) = o;
            if (t >= 6) *(f32x4*)(fs + ((size_t)db * 2 + (t - 6)) * FF + c0) = g;
        }
    }
#undef SUP_STAGE
}

#define XB_TMO      128
#define XB_XCNT(j)  (256  + 64 * (j))
#define XB_XSUB(j)  (1280 + 64 * (j))
#define XB_XGEN(j)  (2304 + 64 * (j))
#define XB_TOP      3328
#define XB_TOPGEN   3392
#define XCD_BAR_WORDS 3456
#define XB_SPIN_CAP (1u << 18)
__device__ __forceinline__ unsigned xb_ld(unsigned* p)              { return __hip_atomic_load(p, __ATOMIC_RELAXED, __HIP_MEMORY_SCOPE_AGENT); }
__device__ __forceinline__ unsigned xb_add(unsigned* p, unsigned v) { return __hip_atomic_fetch_add(p, v, __ATOMIC_RELAXED, __HIP_MEMORY_SCOPE_AGENT); }
__device__ __forceinline__ unsigned xb_xcc_id() { return (unsigned)__builtin_amdgcn_s_getreg((3 << 11) | 20) & 0xFu; }
#define XB_SPIN(cond, bar) do { unsigned _sp = 0; while (cond) { __builtin_amdgcn_s_sleep(1); \
    if ((++_sp & 255u) == 0u) { if (xb_ld(&(bar)[XB_TMO])) break; if (_sp > XB_SPIN_CAP) { atomicAdd(&(bar)[XB_TMO], 1u); break; } } } } while (0)
struct XcdBarrier { unsigned* bar; unsigned x; volatile LAS unsigned* st; };
__device__ __forceinline__ XcdBarrier xcd_barrier_post(unsigned* bar, volatile LAS unsigned* st) {
    XcdBarrier b; b.bar = bar; b.x = xb_xcc_id(); b.st = st;
    if (threadIdx.x == 0) (void)xb_add(&bar[XB_XCNT(b.x)], 1u);
    return b;
}
__device__ __forceinline__ void xcd_barrier_complete(unsigned* bar, unsigned x, unsigned& nloc, unsigned& nx) {
    const unsigned G = gridDim.x * gridDim.y * gridDim.z;
    unsigned sum, cnt, mine, sp = 0u;
    for (;;) {
        sum = 0u; cnt = 0u; mine = 0u;
#pragma unroll
        for (unsigned j = 0; j < 16; ++j) { const unsigned c = xb_ld(&bar[XB_XCNT(j)]); sum += c; cnt += (c > 0u) ? 1u : 0u; mine = (j == x) ? c : mine; }
        if (sum == G) break;
        __builtin_amdgcn_s_sleep(1);
        if ((++sp & 255u) == 0u) { if (xb_ld(&bar[XB_TMO])) break; if (sp > XB_SPIN_CAP) { atomicAdd(&bar[XB_TMO], 1u); break; } }
    }
    nloc = mine > 0u ? mine : 1u; nx = cnt > 0u ? cnt : 1u;
}
__device__ __forceinline__ void xcd_barrier(const XcdBarrier& b) {
    asm volatile("s_waitcnt vmcnt(0)" ::: "memory");
    __syncthreads();
    if (threadIdx.x == 0) {
        unsigned* bar = b.bar;
        __builtin_amdgcn_s_waitcnt(0);
        unsigned nloc = b.st[0], nx = b.st[1];
        if (nloc == 0u) { xcd_barrier_complete(bar, b.x, nloc, nx); b.st[0] = nloc; b.st[1] = nx; }
        const unsigned old = xb_add(&bar[XB_XSUB(b.x)], 1u);
        const unsigned gen = old / nloc;
        if (old + 1u == (gen + 1u) * nloc) {
            __builtin_amdgcn_fence(__ATOMIC_RELEASE, "agent");
            asm volatile("s_waitcnt vmcnt(0)" ::: "memory");
            const unsigned og = xb_add(&bar[XB_TOP], 1u);
            const unsigned tg = og / nx;
            if (og + 1u == (tg + 1u) * nx) xb_add(&bar[XB_TOPGEN], 1u);
            else XB_SPIN(xb_ld(&bar[XB_TOPGEN]) == tg, bar);
            __builtin_amdgcn_fence(__ATOMIC_ACQUIRE, "agent");
            asm volatile("s_waitcnt vmcnt(0)" ::: "memory");
        } else {
            XB_SPIN(xb_ld(&bar[XB_TOPGEN]) == gen, bar);
            __builtin_amdgcn_fence(__ATOMIC_ACQUIRE, "agent");
            asm volatile("s_waitcnt vmcnt(0)" ::: "memory");
        }
    }
    __syncthreads();
}

struct Args { const float* in[34]; float* out; unsigned char* ws; int ph_lo, ph_hi; unsigned char tab[64]; };
typedef const __attribute__((address_space(4))) Args* ArgsP;
#define IN(k) ((const float*)(const GAS float*)(Ap->in[k]))

__device__ __forceinline__ float wave_sum(float v) {
    v = sum8(v); v += dppf<0x140>(v);
    return sum16_32(v);
}
__device__ __forceinline__ void tr_item(const float* W, int ldw, int c0, const float* gain, f16* Wt, int K, int n0, int k0, LAS float* scr, int lane) {
    f32x4 ld[8];
#pragma unroll
    for (int i = 0; i < 8; ++i) ld[i] = *(const f32x4*)(W + (size_t)(k0 + 8 * i + (lane >> 3)) * ldw + c0 + 4 * (lane & 7));
#pragma unroll
    for (int i = 0; i < 8; ++i) { const int kk = 8 * i + (lane >> 3); f32x4 w = ld[i]; if (gain) w = w * gain[k0 + kk];
        LAS float* d = scr + kk * 33 + 4 * (lane & 7); d[0] = w[0]; d[1] = w[1]; d[2] = w[2]; d[3] = w[3]; }
    asm volatile("s_waitcnt lgkmcnt(0)" ::: "memory");
    const int c = lane & 7;
#pragma unroll
    for (int j = 0; j < 4; ++j) { const int n = (lane >> 3) + 8 * j; const LAS float* s = scr + (8 * c) * 33 + n;
        u32x4 o; o.x = pk2h(s[0 * 33], s[1 * 33]); o.y = pk2h(s[2 * 33], s[3 * 33]); o.z = pk2h(s[4 * 33], s[5 * 33]); o.w = pk2h(s[6 * 33], s[7 * 33]);
        *(u32x4*)(Wt + (size_t)(n0 + n) * K + k0 + 8 * c) = o; }
    asm volatile("s_waitcnt lgkmcnt(0)" ::: "memory");
}
__device__ const unsigned char REL_BUCKET[128] = {0,1,2,3,4,5,6,7,8,9,10,11,12,13,14,15,16,16,16,17,17,18,18,18,19,19,19,20,20,20,20,21,21,21,21,22,22,22,22,22,23,23,23,23,23,23,24,24,24,24,24,24,25,25,25,25,25,25,25,26,26,26,26,26,26,26,26,27,27,27,27,27,27,27,27,27,27,28,28,28,28,28,28,28,28,28,28,29,29,29,29,29,29,29,29,29,29,29,29,30,30,30,30,30,30,30,30,30,30,30,30,30,30,31,31,31,31,31,31,31,31,31,31,31,31,31,31,31};

constexpr int KVC_ITEMS = 2 * NDB * 128 * 32, KVC_SPLIT = KVC_ITEMS / 8 * 5;
__device__ __forceinline__ void kvcache_items(ArgsP Ap, unsigned char* ws, float* out, int lo, int hi, int gt, int NT) {
    for (int id0 = lo + gt; id0 < hi; id0 += 4 * NT) {
        f32x4 a[4], b[4];
#pragma unroll
        for (int k = 0; k < 4; ++k) { const int id = id0 + k * NT; if (id < hi) { const int isv = id >= NDB * 128 * 32; const int r = isv ? id - NDB * 128 * 32 : id;
            const float* src = IN(isv ? 6 : 5) + (size_t)r * 8; a[k] = *(const f32x4*)src; b[k] = *(const f32x4*)(src + 4); } }
#pragma unroll
        for (int k = 0; k < 4; ++k) { const int id = id0 + k * NT; if (id < hi) { const int isv = id >= NDB * 128 * 32; const int r = isv ? id - NDB * 128 * 32 : id;
            const int c8 = r & 31, key = (r >> 5) & 127, db = r >> 12;
            u32x4 h; h.x = pk2h(a[k].x, a[k].y); h.y = pk2h(a[k].z, a[k].w); h.z = pk2h(b[k].x, b[k].y); h.w = pk2h(b[k].z, b[k].w);
            *(u32x4*)((f16*)(ws + (isv ? WS_VS16 : WS_KS16)) + ((size_t)db * 160 + key) * 256 + c8 * 8) = h;
            if (key >= 8) { float* o = out + (isv ? O_VS : O_KS) + ((size_t)db * 128 + key - 8) * 256 + c8 * 8; *(f32x4*)o = a[k]; *(f32x4*)(o + 4) = b[k]; } } }
    }
}
__device__ __forceinline__ void kvcache_zero(unsigned char* ws, int gt, int NT) {
    for (int id = gt; id < 2 * NDB * 24 * 32; id += NT) {
        const int isv = id >= NDB * 24 * 32; const int r = isv ? id - NDB * 24 * 32 : id; const int c8 = r & 31, key = 136 + (r >> 5) % 24, db = (r >> 5) / 24;
        unsigned z0 = 0u; asm volatile("" : "+v"(z0));
        *(u32x4*)((f16*)(ws + (isv ? WS_VS16 : WS_KS16)) + ((size_t)db * 160 + key) * 256 + c8 * 8) = (u32x4){z0, z0, z0, z0};
    }
}

__device__ __forceinline__ void phase_prep(ArgsP Ap, unsigned char* ws, float* out, LAS unsigned char* lds, int vcu, int G, int tid, int lane, int wave) {
    LAS float* scr = (LAS float*)(lds + wave * 16384);
    const int gw = vcu * 8 + wave, NGW = G * 8;
    constexpr int I_IN = 16 * 64, I_G = 4 * 64, I_OUT = 16 * 32, I_UP = 16 * 192, I_DN = 48 * 32, I_Q = 16 * 32, I_O = 16 * 32, I_KV = 16 * 16;
    constexpr int NITEMS = 2 * I_IN + 2 * I_G + 2 * I_OUT + 4 * I_UP + 4 * I_DN + 2 * I_Q + 2 * I_O + I_KV;
    for (int it = gw; it < NITEMS; it += NGW) {
        int r = it;
        if (r < 2 * I_IN) { const int l = r / I_IN; r %= I_IN; const int kb = r / 64, nb = r % 64;
            tr_item(IN(8) + (size_t)l * 1024 * 2048, 2048, 32 * nb, IN(7) + l * 1024, (f16*)(ws + WS_WIN + l * 4 * MiB), 1024, 32 * nb, 64 * kb, scr, lane); continue; } r -= 2 * I_IN;
        if (r < 2 * I_G) { const int l = r / I_G; r %= I_G; const int kb = r / 64, nb = r % 64;
            const int pn = nb >> 3, bj = (nb >> 2) & 1, blk = pn >> 1, dcol = 128 * (pn & 1) + 32 * (nb & 3);
            const float* W = (bj ? IN(13) : IN(11)) + ((size_t)l * 4 + blk) * 65536;
            tr_item(W, 256, dcol, nullptr, (f16*)(ws + WS_WG + l * 1 * MiB), 256, 32 * nb, 64 * kb, scr, lane); continue; } r -= 2 * I_G;
        if (r < 2 * I_OUT) { const int l = r / I_OUT; r %= I_OUT; const int kb = r / 32, nb = r % 32;
            tr_item(IN(16) + (size_t)l * 1024 * 1024, 1024, 32 * nb, nullptr, (f16*)(ws + WS_WOUT + l * 2 * MiB), 1024, 32 * nb, 64 * kb, scr, lane); continue; } r -= 2 * I_OUT;
        if (r < 4 * I_UP) { const int l = r / I_UP; r %= I_UP; const int kb = r / 192, nb = r % 192;
            const int pn = nb >> 3, bj = (nb >> 2) & 1, c0 = (bj ? FF : 0) + 128 * pn + 32 * (nb & 3);
            tr_item(IN(30) + (size_t)l * 1024 * 6144, 6144, c0, IN(29) + l * 1024, (f16*)(ws + WS_WUP + l * 12 * MiB), 1024, 32 * nb, 64 * kb, scr, lane); continue; } r -= 4 * I_UP;
        if (r < 4 * I_DN) { const int l = r / I_DN; r %= I_DN; const int kb = r / 32, nb = r % 32;
            tr_item(IN(33) + (size_t)l * 3072 * 1024, 1024, 32 * nb, nullptr, (f16*)(ws + WS_WDN + l * 6 * MiB), 3072, 32 * nb, 64 * kb, scr, lane); continue; } r -= 4 * I_DN;
        if (r < 2 * I_Q) { const int l = r / I_Q; r %= I_Q; const int kb = r / 32, nb = r % 32;
            const int c0 = 32 * (8 * (nb >> 3) + 2 * (nb & 3) + ((nb >> 2) & 1));
            tr_item(IN(22) + (size_t)l * 1024 * 1024, 1024, c0, IN(21) + l * 1024, (f16*)(ws + WS_WQ + l * 2 * MiB), 1024, 32 * nb, 64 * kb, scr, lane); continue; } r -= 2 * I_Q;
        if (r < 2 * I_O) { const int l = r / I_O; r %= I_O; const int kb = r / 32, nb = r % 32;
            tr_item(IN(26) + (size_t)l * 1024 * 1024, 1024, 32 * nb, nullptr, (f16*)(ws + WS_WO + l * 2 * MiB), 1024, 32 * nb, 64 * kb, scr, lane); continue; } r -= 2 * I_O;
        { const int kb = r / 16, nb = r % 16; const int c0 = 32 * (8 * (nb >> 3) + 2 * (nb & 3) + ((nb >> 2) & 1));
            tr_item(IN(18), 512, c0, IN(17), (f16*)(ws + WS_WKV), 1024, 32 * nb, 64 * kb, scr, lane); }
    }
    f16* X16 = (f16*)(ws + WS_X16); float* SS = (float*)(ws + WS_SS);
    for (int m = gw; m < M; m += NGW) {
        const float* xrow = m < MP ? IN(0) + (size_t)m * 1024 : IN(1) + (size_t)(m - MP) * 1024;
        const f32x4* xr = (const f32x4*)xrow + lane; float s = 0.f;
        u32x2* o8 = (u32x2*)(X16 + (size_t)m * 1024) + lane;
#pragma unroll
        for (int j = 0; j < 4; ++j) { const f32x4 v = xr[64 * j]; s += (v.x * v.x + v.y * v.y) + (v.z * v.z + v.w * v.w); u32x2 h; h.x = pk2h(v.x, v.y); h.y = pk2h(v.z, v.w); o8[64 * j] = h; }
        s = wave_sum(s);
        if (lane < 16) SS[(size_t)m * 16 + lane] = lane == 0 ? s : 0.f;
    }
    const int gt = vcu * 512 + tid, NT = G * 512;
    kvcache_items(Ap, ws, out, KVC_SPLIT, KVC_ITEMS, gt, NT); kvcache_zero(ws, gt, NT);
    float* CST = (float*)(ws + WS_CONST);
    for (int id = gt; id < 2048; id += NT) { const float lam = IN(15)[id]; const float e = __builtin_amdgcn_exp2f(-lam * LOG2E);
        const float ser = e * (1.0f + e * (-0.5f + e * (0.33333334f + e * (-0.25f + e * 0.2f))));
        const float sp = e < 0.05f ? ser : __builtin_amdgcn_logf(1.0f + e) * 0.6931471806f;
        CST[C_SP2 + id] = 8.0f * sp * LOG2E; }
    for (int id = gt; id < 2048; id += NT) { const int h = id >> 7, dist = id & 127; CST[C_BIAS2 + id] = IN(28)[REL_BUCKET[dist] * 16 + h] * LOG2E; }
    for (int id = gt; id < 32; id += NT) CST[C_SINK2 + id] = IN(25)[id] * LOG2E;
}


__device__ __forceinline__ void convfix_block(const f16* XF, const f16* XL, f16* XC, const float* cw, const float* cb, int pm, int col0, int first, int nthr) {
    for (int id = first; id < 4 * 3 * 32; id += nthr) {
        const int c0 = col0 + (id & 31) * 8, cr = id >> 5, r = cr % 3, cidx = 4 * pm + cr / 3;
        const bool seq0 = (cidx & 63) == 0;
        float x[4][8];
#pragma unroll
        for (int k = 0; k < 4; ++k) {
            const int p = r - k;
            if (p >= 0) ld8(XF + ((size_t)cidx * 3 + p) * 1024 + c0, x[k]);
            else if (!seq0) ld8(XL + ((size_t)(cidx - 1) * 3 + (3 + p)) * 1024 + c0, x[k]);
            else {
#pragma unroll
                for (int i = 0; i < 8; ++i) x[k][i] = 0.f; }
        }
        float o[8];
#pragma unroll
        for (int i = 0; i < 8; ++i) o[i] = cb[c0 + i] + cw[3072 + c0 + i] * x[0][i] + cw[2048 + c0 + i] * x[1][i] + cw[1024 + c0 + i] * x[2][i] + cw[c0 + i] * x[3][i];
        st8(XC + ((size_t)cidx * 64 + r) * 1024 + c0, o);
    }
}

__device__ __forceinline__ void phase_scan2(const f16* HL, const f16* AC, const f16* GG, f16* Y, const float* P, const float* Hl, const float* hst  , float* hp  , float* hs  , int gt, int NT) {
    for (int id = gt; id < 4 * 64 * 512 + NDB * 128; id += NT) {
        float c[8]; size_t row0; int nstep; float* fin = nullptr; int cg;
        if (id < 4 * 64 * 512) {
            cg = id & 127; const int rq = (id >> 7) & 3, bc = id >> 9, ch = bc & 63, b = bc >> 6;
#pragma unroll
            for (int i = 0; i < 8; ++i) c[i] = 0.f;
            const float* Pb = P + (size_t)(b * 64) * 1024 + cg * 8; const float* Hb = Hl + (size_t)(b * 64) * 1024 + cg * 8;
            int j = 0;
            for (; j + 4 <= ch; j += 4) {
                f32x4 p[4][2], q[4][2];
#pragma unroll
                for (int k = 0; k < 4; ++k) { p[k][0] = *(const f32x4*)(Pb + (size_t)(j + k) * 1024); p[k][1] = *(const f32x4*)(Pb + (size_t)(j + k) * 1024 + 4);
                                              q[k][0] = *(const f32x4*)(Hb + (size_t)(j + k) * 1024); q[k][1] = *(const f32x4*)(Hb + (size_t)(j + k) * 1024 + 4); }
#pragma unroll
                for (int k = 0; k < 4; ++k)
#pragma unroll
                    for (int i = 0; i < 8; ++i) c[i] = p[k][i >> 2][i & 3] * c[i] + q[k][i >> 2][i & 3];
            }
            for (; j < ch; ++j) { const f32x4 p0 = *(const f32x4*)(Pb + (size_t)j * 1024), p1 = *(const f32x4*)(Pb + (size_t)j * 1024 + 4), q0 = *(const f32x4*)(Hb + (size_t)j * 1024), q1 = *(const f32x4*)(Hb + (size_t)j * 1024 + 4);
#pragma unroll
                for (int i = 0; i < 4; ++i) { c[i] = p0[i] * c[i] + q0[i]; c[4 + i] = p1[i] * c[4 + i] + q1[i]; } }
            row0 = (size_t)bc * 64 + rq * 16; nstep = 16; if (ch == 63 && rq == 3) fin = hp + b * 1024 + cg * 8;
        } else {
            const int r = id - 4 * 64 * 512; cg = r & 127; const int db = r >> 7;
            const f32x4 q0 = *(const f32x4*)(hst + (size_t)db * 1024 + cg * 8), q1 = *(const f32x4*)(hst + (size_t)db * 1024 + cg * 8 + 4);
#pragma unroll
            for (int i = 0; i < 4; ++i) { c[i] = q0[i]; c[4 + i] = q1[i]; }
            row0 = (size_t)MP + db * 8; nstep = 8; fin = hs + (size_t)db * 1024 + cg * 8;
        }
        const f16* hl = HL + row0 * 1024 + cg * 8; const f16* ac = AC + row0 * 1024 + cg * 8; const f16* gg = GG + row0 * 1024 + cg * 8; f16* y = Y + row0 * 1024 + cg * 8;
        float h[8];
#pragma unroll
        for (int i = 0; i < 8; ++i) h[i] = 0.f;
#pragma unroll 4
        for (int s = 0; s < nstep; ++s) {
            const f16x8 l = *(const f16x8*)(hl + (size_t)s * 1024), a = *(const f16x8*)(ac + (size_t)s * 1024), g = *(const f16x8*)(gg + (size_t)s * 1024);
            float o[8];
#pragma unroll
            for (int i = 0; i < 8; ++i) { h[i] = (float)l[i] + (float)a[i] * c[i]; o[i] = (float)g[i] * h[i]; }
            st8(y + (size_t)s * 1024, o);
        }
        if (fin) { *(f32x4*)fin = (f32x4){h[0], h[1], h[2], h[3]}; *(f32x4*)(fin + 4) = (f32x4){h[4], h[5], h[6], h[7]}; }
    }
}

__device__ __forceinline__ void fix_panel(const f16* GF, const f16* VF, const f16* GL, f16* H, const float* cw, const float* cb, int pm, int first, int nthr) {
    for (int id = first; id < 4 * 2 * 384; id += nthr) {
        const int cg = id % 384, cr = id / 384, r = cr & 1, cidx = 4 * pm + (cr >> 1), c0 = cg * 8;
        float g0[8], v[8], gm1[8], gm2[8];
        ld8(GF + ((size_t)cidx * 2 + r) * FF + c0, g0); ld8(VF + ((size_t)cidx * 2 + r) * FF + c0, v);
        const bool first = (cidx & 63) == 0;
#pragma unroll
        for (int i = 0; i < 8; ++i) { gm1[i] = 0.f; gm2[i] = 0.f; }
        if (r == 1) { ld8(GF + ((size_t)cidx * 2) * FF + c0, gm1); if (!first) ld8(GL + ((size_t)(cidx - 1) * 2 + 1) * FF + c0, gm2); }
        else if (!first) { ld8(GL + ((size_t)(cidx - 1) * 2 + 1) * FF + c0, gm1); ld8(GL + ((size_t)(cidx - 1) * 2) * FF + c0, gm2); }
        float h[8];
#pragma unroll
        for (int i = 0; i < 8; ++i) { const float gc = cb[c0 + i] + cw[c0 + i] * gm2[i] + cw[FF + c0 + i] * gm1[i] + cw[2 * FF + c0 + i] * g0[i]; h[i] = gelu_t(gc) * v[i]; }
        st8(H + ((size_t)cidx * 64 + r) * FF + c0, h);
    }
}

__device__ __forceinline__ int crow(int r, int hi) { return (r & 3) + 8 * (r >> 2) + 4 * hi; }
constexpr int ATT_K = 0, ATT_V = 32768, ATT_BIAS = 81920, ATT_STG = 106496;
constexpr int ATT_SK = 20480, ATT_SV = 40960;
__device__ __forceinline__ void attn_group(LAS unsigned char* lds, const f16* Q, f16* O, int qrow, int head, int qoff, int sjmin, int tile0, float sink2, int lane, int wave, int omode, int orow0, int ohead0, int koff, int voff) {
    const int q31 = lane & 31, hi = lane >> 5;
    f16x8 qf[4];
#pragma unroll
    for (int ds = 0; ds < 4; ++ds) qf[ds] = *(const f16x8*)(Q + (size_t)qrow * 1024 + head * 64 + ds * 16 + hi * 8);
    f32x16 s[5];
#pragma unroll
    for (int kt = 0; kt < 5; ++kt) {
        const int key = (tile0 + kt) * 32 + q31;
        f32x16 a = {};
#pragma unroll
        for (int ds = 0; ds < 4; ++ds) {
            const f16x8 kf = *(const LAS f16x8*)(lds + koff + key * 128 + (((ds * 2 + hi) ^ (key & 7)) << 4));
            a = __builtin_amdgcn_mfma_f32_32x32x16_f16(kf, qf[ds], a, 0, 0, 0);
        }
        s[kt] = a;
    }
    float mx = sink2;
    if (sjmin == 0) {
        const LAS float* tb = (const LAS float*)(lds + ATT_BIAS) + head * 384 + 128 + (qoff - 32 * tile0 - 4 * hi);
#pragma unroll
        for (int kt = 0; kt < 5; ++kt)
#pragma unroll
            for (int r = 0; r < 16; ++r) { const float sc = s[kt][r] + tb[-(32 * kt + (r & 3) + 8 * (r >> 2))]; s[kt][r] = sc; mx = fmaxf(mx, sc); }
    } else {
        const LAS float* tb = (const LAS float*)(lds + ATT_BIAS) + head * 384 + 128;
#pragma unroll
        for (int kt = 0; kt < 5; ++kt)
#pragma unroll
            for (int r = 0; r < 16; ++r) {
                const int sj = (tile0 + kt) * 32 + crow(r, hi); const int dist = qoff - sj;
                const float sc = (sj >= sjmin) ? s[kt][r] + tb[dist] : -1e30f;
                s[kt][r] = sc; mx = fmaxf(mx, sc);
            }
    }
    mx = fmaxf(mx, other32f(mx));
    float l = 0.f;
#pragma unroll
    for (int kt = 0; kt < 5; ++kt)
#pragma unroll
        for (int r = 0; r < 16; ++r) { const float p = __builtin_amdgcn_exp2f(s[kt][r] - mx); s[kt][r] = p; l += p; }
    l += other32f(l);
    const float rden = __builtin_amdgcn_rcpf(l + __builtin_amdgcn_exp2f(sink2 - mx));
    f32x16 o[2]; o[0] = (f32x16){}; o[1] = (f32x16){};
#pragma unroll
    for (int kt = 0; kt < 5; ++kt)
#pragma unroll
        for (int s2 = 0; s2 < 2; ++s2) {
            u32x4 pw; pw.x = pk2h(s[kt][8 * s2 + 0], s[kt][8 * s2 + 1]); pw.y = pk2h(s[kt][8 * s2 + 2], s[kt][8 * s2 + 3]); pw.z = pk2h(s[kt][8 * s2 + 4], s[kt][8 * s2 + 5]); pw.w = pk2h(s[kt][8 * s2 + 6], s[kt][8 * s2 + 7]);
            const f16x8 pb = __builtin_bit_cast(f16x8, pw);
            const int ka = (tile0 + kt) * 32 + 16 * s2 + 4 * hi + ((lane & 15) >> 2), kb = ka + 8;
#pragma unroll
            for (int db = 0; db < 2; ++db) {
                const int col = 32 * db + 16 * ((lane >> 4) & 1) + 4 * (lane & 3);
                const s16x4 lo = __builtin_amdgcn_ds_read_tr16_b64_v4i16((LAS s16x4*)(lds + voff + ka * 128 + ((((col >> 3) ^ (ka & 7)) << 4) | ((col & 7) * 2))));
                const s16x4 hh = __builtin_amdgcn_ds_read_tr16_b64_v4i16((LAS s16x4*)(lds + voff + kb * 128 + ((((col >> 3) ^ (kb & 7)) << 4) | ((col & 7) * 2))));
                typedef short s16x8 __attribute__((ext_vector_type(8)));
                const s16x8 vv = {lo[0], lo[1], lo[2], lo[3], hh[0], hh[1], hh[2], hh[3]};
                o[db] = __builtin_amdgcn_mfma_f32_32x32x16_f16(__builtin_bit_cast(f16x8, vv), pb, o[db], 0, 0, 0);
            }
        }
    LAS unsigned char* stg = lds + ATT_STG + wave * 4608;
#pragma unroll
    for (int db = 0; db < 2; ++db)
#pragma unroll
        for (int c = 0; c < 4; ++c) {
            u32x2 h; h.x = pk2h(o[db][4 * c] * rden, o[db][4 * c + 1] * rden); h.y = pk2h(o[db][4 * c + 2] * rden, o[db][4 * c + 3] * rden);
            *(LAS u32x2*)(stg + q31 * 144 + (32 * db + 8 * c + 4 * hi) * 2) = h;
        }
#pragma unroll
    for (int i = 0; i < 4; ++i) {
        const int r = 8 * i + (lane >> 3), ch = lane & 7;
        const u32x4 v = *(const LAS u32x4*)(stg + r * 144 + ch * 16);
        const int grow = omode ? orow0 + (r & 7) : orow0 + r, ghead = omode ? ohead0 + (r >> 3) : ohead0;
        *(u32x4*)(O + (size_t)grow * 1024 + ghead * 64 + ch * 8) = v;
    }
}
__device__ __forceinline__ void phase_attn(LAS unsigned char* lds, const f16* Q, f16* O, const f16* K16, const f16* V16, const f16* KS16, const f16* VS16, const float* bias2, const float* sink2,
                                           int vcu, int G, int tid, int lane, int wave) {
    LAS float* bt = (LAS float*)(lds + ATT_BIAS);
    {   float bv[4];
#pragma unroll
        for (int k = 0; k < 4; ++k) bv[k] = bias2[tid + 512 * k];
#pragma unroll
        for (int k = 0; k < 8; ++k) { const int i = tid + 512 * k, h = i >> 8, r = i & 255; bt[h * 384 + (r < 128 ? r : r + 128)] = -1e30f; }
#pragma unroll
        for (int k = 0; k < 4; ++k) { const int i = tid + 512 * k; bt[(i >> 7) * 384 + 128 + (i & 127)] = bv[k]; }
    }
    for (int unit = vcu; unit < 768; unit += G) {
        __syncthreads();
        const bool samp = unit >= 512;
        int b = 0, kvh = 0, j = 0, db = 0;
        if (!samp) {
            b = unit >> 7; kvh = (unit >> 5) & 3; j = unit & 31;
#pragma unroll
            for (int i = 0; i < 4; ++i) {
                const int c = tid + 512 * i, key = c >> 3, ch = c & 7;
                u32x4 kv = {0u, 0u, 0u, 0u}, vv = {0u, 0u, 0u, 0u};
                if (j > 0 || key >= 128) { const size_t row = (size_t)(b * 4096 + (j - 1) * 128 + key); kv = *(const u32x4*)(K16 + row * 256 + kvh * 64 + ch * 8); vv = *(const u32x4*)(V16 + row * 256 + kvh * 64 + ch * 8); }
                const int off = key * 128 + ((ch ^ (key & 7)) << 4);
                *(LAS u32x4*)(lds + ATT_K + off) = kv; *(LAS u32x4*)(lds + ATT_V + off) = vv;
            }
        } else {
            const int p = unit - 512; db = p >> 1; kvh = 2 * (p & 1);
#pragma unroll
            for (int i = 0; i < 5; ++i) {
                const int c = tid + 512 * i, key = c >> 4, c16 = c & 15, ub = c16 >> 3, ch = c16 & 7;
                const size_t g = ((size_t)db * 160 + key) * 256 + kvh * 64 + c16 * 8;
                const u32x4 kv = *(const u32x4*)(KS16 + g), vv = *(const u32x4*)(VS16 + g);
                const int off = ub * ATT_SK + key * 128 + ((ch ^ (key & 7)) << 4);
                *(LAS u32x4*)(lds + off) = kv; *(LAS u32x4*)(lds + ATT_SV + off) = vv;
            }
        }
        __syncthreads();
        if (!samp) {
            const int g = wave >> 1, half = wave & 1, head = kvh * 4 + g;
            const float sk = sink2[head];
#pragma unroll 1
            for (int grp = 0; grp < 2; ++grp) {
                const int qi = 64 * half + 32 * grp + (lane & 31);
                attn_group(lds, Q, O, b * 4096 + j * 128 + qi, head, qi + 128, j == 0 ? 128 : 0, 2 * half + grp, sk, lane, wave, 0, b * 4096 + j * 128 + 64 * half + 32 * grp, head, ATT_K, ATT_V);
            }
        } else if (wave < 2) {
            const int q = lane & 31, g = q >> 3, t = q & 7, head = (kvh + wave) * 4 + g;
            attn_group(lds, Q, O, MP + db * 8 + t, head, t + 128, 0, 0, sink2[head], lane, wave, 1, MP + db * 8, (kvh + wave) * 4, wave * ATT_SK, ATT_SV + wave * ATT_SK);
        }
    }
    __syncthreads();
}

enum PhaseKind { PK_PREP, PK_IN, PK_GATE, PK_SCAN2, PK_OUT, PK_UP, PK_DOWN, PK_KV, PK_Q, PK_ATTN, PK_WO };
constexpr int NPHASE = 21;
__host__ __device__ __forceinline__ int base_kind(int b) {
    if (b == 0) return PK_PREP;
    if (b <= 10) { const int p = (b - 1) % 5; return p == 0 ? PK_IN : p == 1 ? PK_GATE : p == 2 ? PK_OUT : p == 3 ? PK_UP : PK_DOWN; }
    if (b == 11) return PK_KV;
    const int p = b <= 15 ? b - 11 : b - 16; return p == 0 ? PK_Q : p == 1 ? PK_ATTN : p == 2 ? PK_WO : p == 3 ? PK_UP : PK_DOWN; }
__device__ __forceinline__ void phase_decode(int ph, int& kind, int& layer) {
    kind = base_kind(ph);
    layer = ph == 0 ? 0 : ph <= 10 ? (ph - 1) / 5 : ph == 11 ? 1 : ph <= 15 ? 2 : 3;
}
__host__ __device__ __forceinline__ int nphase_total() { int n = 0; for (int b = 0; b < NPHASE; ++b) n += (base_kind(b) == PROBE_KIND) ? PROBE_REP : 1; return n; }
__device__ __forceinline__ void phase_decode_x(int ph, int& kind, int& layer, bool& dry, bool& probe_extra) {
#if PROBE_KIND >= 0
    const int code = ((const __attribute__((address_space(4))) unsigned char*)__builtin_amdgcn_kernarg_segment_ptr())[__builtin_offsetof(Args, tab) + ph];
    const int b = code & 63;
    probe_extra = (code >> 6) != 0;
#if PROBE_KIND == 4 || PROBE_KIND == 6 || PROBE_KIND == 10
    dry = probe_extra;
#else
    dry = false;
#endif
    phase_decode(b, kind, layer);
#else
    dry = false; probe_extra = false; phase_decode(ph, kind, layer);
#endif
}
__global__ void __launch_bounds__(512, 2) yoco_fwd(Args A) {
    extern __shared__ __attribute__((aligned(16))) unsigned char lds_raw[];
    LAS unsigned char* lds = (LAS unsigned char*)lds_raw;
    const int tid0 = threadIdx.x;
    const int wave0 = __builtin_amdgcn_readfirstlane(tid0 >> 6);
    const int G = gridDim.x; const int bx = blockIdx.x; const int vcu = (G % 8 == 0) ? (bx % 8) * (G / 8) + bx / 8 : bx;
    volatile LAS unsigned* MISC = (volatile LAS unsigned*)(lds + MISC_OFF);
    for (int u = tid0; u < (LDS_BYTES - LDSCTL_OFF) / 4; u += 512) ((LAS unsigned*)(lds + LDSCTL_OFF))[u] = 0u;
    __syncthreads();
    XcdBarrier bar; bar.bar = (unsigned*)(A.ws + WS_CTL) + CW_BAR; bar.x = 0; bar.st = nullptr;
    const bool multi = (A.ph_hi - A.ph_lo) > 1;
    if (multi) bar = xcd_barrier_post((unsigned*)(A.ws + WS_CTL) + CW_BAR, MISC + 8);

    for (int ph = A.ph_lo; ph < A.ph_hi; ++ph) {
#define FRESH_TID(name) int name; { int z_ = 0; asm volatile("" : "+v"(z_)); name = wave0 * 64 + (int)__builtin_amdgcn_mbcnt_hi(~0u, __builtin_amdgcn_mbcnt_lo(~0u, (unsigned)z_)); }
#define FRESH_ARGS ArgsP Ap = (ArgsP)__builtin_amdgcn_kernarg_segment_ptr(); asm volatile("" : "+s"(Ap)); \
        unsigned char* ws = (unsigned char*)(GAS unsigned char*)Ap->ws; float* out = (float*)(GAS float*)Ap->out; (void)out; \
        float* CST = (float*)(ws + WS_CONST); float* SS = (float*)(ws + WS_SS); f16* X16 = (f16*)(ws + WS_X16); (void)CST; (void)SS; (void)X16;
        const int NT = G * 512; const int wave = wave0;
        const bool small_first = (bx >> 3) & 1;
        int kind, L; bool dry, probe_extra; phase_decode_x(ph, kind, L, dry, probe_extra); (void)probe_extra;
        pg8::StaticOrder S;
        switch (kind) {
        case PK_PREP: { FRESH_ARGS; FRESH_TID(tid); phase_prep(Ap, ws, out, lds, vcu, G, tid, tid & 63, wave); } break;
        case PK_IN: { FRESH_ARGS; FRESH_TID(tid);
            pg8::Gemm g{X16, (const f16*)(ws + WS_WIN + L * 4 * MiB), MP, 2048, 1024, 1024, 0}; S.init(MP, 2048, G, bx);
            EpiIn E{SS, (f16*)(ws + WS_GG), (f16*)(ws + WS_XC), (f16*)(ws + WS_XF), (f16*)(ws + WS_XL), IN(9) + L * 4 * 1024, IN(10) + L * 1024, out + O_CP + (size_t)L * 4 * 3 * 1024};
            sg::SGemm sgm{X16, 1024, g.Bt, 1024}; SEpiIn SE{SS, E.GG, E.XC, E.cw, E.cb, IN(3) + (size_t)L * NDB * 3 * 1024, out + O_CS + (size_t)L * NDB * 3 * 1024};
#pragma unroll 1
            for (int pass = 0; pass < 2; ++pass) {
                if ((pass == 0) != small_first) { FRESH_TID(tidb); pg8::gemm_phase<EpiIn>(lds, g, S, E, tidb); }
                else if (!PROBE_SKIP_SMALL) { FRESH_TID(tid2); sg::sgemm_staged<SEpiIn>(lds, sgm, 32, SE, vcu, G, tid2); }
            } } break;
        case PK_GATE: { FRESH_ARGS;
            pg8::Gemm g{(const f16*)(ws + WS_XC), (const f16*)(ws + WS_WG + L * MiB), MP, 2048, 256, 1024, 1}; S.init(MP, 2048, G, bx, true);
            EpiGate E{(const f16*)(ws + WS_XC), (const f16*)(ws + WS_GG), (f16*)(ws + WS_Y16), (float*)(ws + WS_PH + L * MiB), (unsigned*)(ws + WS_CTL) + CW_GFLAG + L * 512, out + O_HP + (size_t)L * 4 * 1024,
                      IN(12) + L * 1024, IN(14) + L * 1024, CST + C_SP2 + L * 1024, lds};
            {
                FRESH_TID(tp);
                pg8::Unit uu; for (int i = 0; S.next(i, uu); ++i) convfix_block((const f16*)(ws + WS_XF), (const f16*)(ws + WS_XL), (f16*)(ws + WS_XC), IN(9) + L * 4 * 1024, IN(10) + L * 1024, uu.pm, (uu.pn >> 1) * 256, tp, 512);
                asm volatile("s_waitcnt vmcnt(0)" ::: "memory"); __syncthreads();
            }
            FRESH_TID(tid);
            pg8::gemm_phase<EpiGate>(lds, g, S, E, tid);
            sg::SGemm sgm{g.A, 1024, g.Bt, 256}; SEpiGate SE{nullptr, E.XC, E.GG, E.Y, IN(2) + (size_t)L * NDB * 1024, out + O_HS + (size_t)L * NDB * 1024, E.br, E.bi, E.sp2};
            if (!PROBE_SKIP_SMALL) { FRESH_TID(tid2); sg::sgemm_staged<SEpiGate>(lds, sgm, 32, SE, vcu, G, tid2); } } break;
        case PK_OUT: case PK_WO: case PK_DOWN: { FRESH_ARGS;
            pg8::Gemm g; const float* bias = nullptr; const float* xp = nullptr; const float* xs = nullptr; float* yp = nullptr; float* ys = nullptr;
            if (kind == PK_OUT) { g = pg8::Gemm{(const f16*)(ws + WS_Y16), (const f16*)(ws + WS_WOUT + L * 2 * MiB), MP, 1024, 1024, 1024, 0}; }
            else if (kind == PK_WO) { g = pg8::Gemm{(const f16*)(ws + WS_O16), (const f16*)(ws + WS_WO + (L - 2) * 2 * MiB), MP, 1024, 1024, 1024, 0}; bias = IN(27) + (L - 2) * 1024; }
            else { g = pg8::Gemm{(const f16*)(ws + WS_H16), (const f16*)(ws + WS_WDN + L * 6 * MiB), MP, 1024, 3072, 3072, 0}; if (L == 3) { yp = out; ys = out + (size_t)MP * 1024; } }
            S.init(MP, 1024, G, bx);
            if (kind == PK_DOWN) {
                FRESH_TID(tp);
                pg8::Unit uu; for (int i = 0; S.next(i, uu); ++i) fix_panel((const f16*)(ws + WS_GF), (const f16*)(ws + WS_VF), (const f16*)(ws + WS_GL), (f16*)(ws + WS_H16), IN(31) + (size_t)L * 3 * FF, IN(32) + (size_t)L * FF, uu.pm, tp, 512);
                asm volatile("s_waitcnt vmcnt(0)" ::: "memory"); __syncthreads();
            }
            EpiRes E{xp, yp, X16, SS, bias, dry};
            sg::SGemm sgm{g.A, g.lda, g.Bt, g.K}; SEpiRes SE{xs, ys, X16, SS, bias, dry};
#pragma unroll 1
            for (int pass = 0; pass < 2; ++pass) {
                if ((pass == 0) != small_first) { FRESH_TID(tidb); pg8::gemm_phase<EpiRes>(lds, g, S, E, tidb); }
                else if (!PROBE_SKIP_SMALL) { FRESH_TID(tid2); sg::sgemm_staged<SEpiRes>(lds, sgm, 16, SE, vcu, G, tid2); }
            } } break;
        case PK_UP: { FRESH_ARGS; FRESH_TID(tid);
            pg8::Gemm g{X16, (const f16*)(ws + WS_WUP + L * 12 * MiB), MP, 6144, 1024, 1024, 0}; S.init(MP, 6144, G, bx);
            EpiUp E{SS, (f16*)(ws + WS_H16), (f16*)(ws + WS_GF), (f16*)(ws + WS_VF), (f16*)(ws + WS_GL), IN(31) + (size_t)L * 3 * FF, IN(32) + (size_t)L * FF,
                    IN(4) + (size_t)L * NDB * 2 * FF, out + O_FP + (size_t)L * 4 * 2 * FF, out + O_FS + (size_t)L * NDB * 2 * FF};
#if PROBE_KIND == 5 && defined(PROBE_NULLEPI)
            if (probe_extra) { EpiNull EN{(float*)(ws + WS_GF)}; pg8::gemm_phase<EpiNull>(lds, g, S, EN, tid); break; }
#endif
#pragma unroll 1
            for (int pass = 0; pass < 2; ++pass) {
                if ((pass == 0) != small_first) { FRESH_TID(tidb); pg8::gemm_phase<EpiUp>(lds, g, S, E, tidb); }
                else if (!PROBE_SKIP_SMALL) { FRESH_TID(tid2); sup_phase(lds, X16, g.Bt, SS, E.H, E.cw, E.cb, E.st, E.fs, vcu, G, tid2); }
            } } break;
        case PK_KV: { FRESH_ARGS; FRESH_TID(tid);
            pg8::Gemm g{X16, (const f16*)(ws + WS_WKV), MP, 1536, 1024, 1024, 0}; S.init(MP, 1536, G, bx);
            EpiKVQ E{EpiKV{SS, IN(19), IN(20), (f16*)(ws + WS_K16), (f16*)(ws + WS_V16), (f16*)(ws + WS_KS16), (f16*)(ws + WS_VS16), out}, EpiQ{SS, IN(23), IN(24), (f16*)(ws + WS_Q16)}};
            pg8::gemm_phase<EpiKVQ>(lds, g, S, E, tid);
            sg::SGemm sgm{X16, 1024, g.Bt, 1024}; SEpiKVQ SE{SEpiKV{SS, E.kv.bkv, E.kv.knorm, E.kv.KS16, E.kv.VS16, out}, SEpiQ{SS, E.q.bq, E.q.qnorm, E.q.Q16}, SS};
            const int hidx = bx - G / 2, hcnt = G - G / 2;
            if (!PROBE_SKIP_SMALL) { FRESH_TID(tid2); sg::sgemm_staged<SEpiKVQ>(lds, sgm, 24, SE, hidx >= 0 ? hidx : (1 << 20), hcnt, tid2); }
            if (hidx >= 0) { FRESH_TID(tid3); kvcache_items(Ap, ws, out, 0, KVC_SPLIT, hidx * 512 + tid3, hcnt * 512); } } break;
        case PK_Q: { FRESH_ARGS; FRESH_TID(tid);
            pg8::Gemm g{X16, (const f16*)(ws + WS_WQ + (L - 2) * 2 * MiB), MP, 1024, 1024, 1024, 0}; S.init(MP, 1024, G, bx);
            EpiQ E{SS, IN(23) + (L - 2) * 1024, IN(24) + (L - 2) * 64, (f16*)(ws + WS_Q16)};
            sg::SGemm sgm{X16, 1024, g.Bt, 1024}; SEpiQ SE{SS, E.bq, E.qnorm, E.Q16};
#pragma unroll 1
            for (int pass = 0; pass < 2; ++pass) {
                if ((pass == 0) != small_first) { FRESH_TID(tidb); pg8::gemm_phase<EpiQ>(lds, g, S, E, tidb); }
                else if (!PROBE_SKIP_SMALL) { FRESH_TID(tid2); sg::sgemm_staged<SEpiQ>(lds, sgm, 16, SE, vcu, G, tid2); }
            } } break;
        case PK_ATTN: { FRESH_ARGS; FRESH_TID(tid);
            phase_attn(lds, (const f16*)(ws + WS_Q16), (f16*)(ws + WS_O16), (const f16*)(ws + WS_K16), (const f16*)(ws + WS_V16), (const f16*)(ws + WS_KS16), (const f16*)(ws + WS_VS16),
                       CST + C_BIAS2, CST + C_SINK2 + (L - 2) * 16, vcu, G, tid, tid & 63, wave); } break;
        }
        if (ph + 1 < A.ph_hi) xcd_barrier(bar);
    }
}

extern "C" void kernel_launch(void* const* d_in, const int* in_sizes, int n_in, void* d_out, int out_size, void* d_ws, size_t ws_size, hipStream_t stream) {
    static int grid = 0;
    if (grid == 0) {
        if (n_in != 34 || out_size != (int)O_END || ws_size < WS_END) { fprintf(stderr, "kernel_launch: unexpected shapes: n_in %d out %d ws %zu (need %zu)\n", n_in, out_size, ws_size, (size_t)WS_END); grid = -1; return; }
        int dev = 0, cus = 0;
        if (hipGetDevice(&dev) != hipSuccess || hipDeviceGetAttribute(&cus, hipDeviceAttributeMultiprocessorCount, dev) != hipSuccess) { grid = -1; return; }
        if (hipFuncSetAttribute((const void*)yoco_fwd, hipFuncAttributeMaxDynamicSharedMemorySize, LDS_BYTES) != hipSuccess) { fprintf(stderr, "kernel_launch: hipFuncSetAttribute failed\n"); grid = -1; return; }
        int per_cu = 0;
        if (hipOccupancyMaxActiveBlocksPerMultiprocessor(&per_cu, (const void*)yoco_fwd, 512, LDS_BYTES) != hipSuccess || per_cu < 1) fprintf(stderr, "kernel_launch: occupancy query says %d blocks per CU\n", per_cu);
        (void)hipGetLastError();
        grid = cus;
    }
    if (grid < 0) return;
    (void)hipMemsetAsync((char*)d_ws + WS_CTL, 0, CTL_ZERO_BYTES, stream);
    Args a{};
    for (int i = 0; i < 34; ++i) a.in[i] = (const float*)d_in[i];
    a.out = (float*)d_out; a.ws = (unsigned char*)d_ws;
#if MK_PER_PHASE
    for (int ph = 0; ph < NPHASE; ++ph) { a.ph_lo = ph; a.ph_hi = ph + 1; hipLaunchKernelGGL(yoco_fwd, dim3(grid), dim3(512), LDS_BYTES, stream, a); }
#else
    a.ph_lo = 0; a.ph_hi = nphase_total();
#if PROBE_KIND >= 0
    { int n = 0; for (int b = 0; b < NPHASE; ++b) { const int r = (base_kind(b) == PROBE_KIND) ? PROBE_REP : 1; for (int k = 0; k < r; ++k) a.tab[n++] = (unsigned char)(b | (k > 0 ? 64 : 0)); } }
#endif
    hipLaunchKernelGGL(yoco_fwd, dim3(grid), dim3(512), LDS_BYTES, stream, a);
#endif
}
```

```cpp
#include <hip/hip_runtime.h>
#include <cstdio>
#include <cstdint>

#ifndef MK_PER_PHASE
#define MK_PER_PHASE 0
#endif

#ifndef PROBE_KIND
#define PROBE_KIND -1
#endif
#ifndef PROBE_REP
#define PROBE_REP 1
#endif
#ifdef PROBE_NOSMALL
#define PROBE_SKIP_SMALL probe_extra
#else
#define PROBE_SKIP_SMALL false
#endif
#define LAS __attribute__((address_space(3)))
#define GAS __attribute__((address_space(1)))
typedef _Float16 f16;
typedef _Float16 f16x2 __attribute__((ext_vector_type(2)));
typedef _Float16 f16x4 __attribute__((ext_vector_type(4)));
typedef _Float16 f16x8 __attribute__((ext_vector_type(8)));
typedef float f32x2 __attribute__((ext_vector_type(2)));
typedef float f32x4 __attribute__((ext_vector_type(4)));
typedef float f32x16 __attribute__((ext_vector_type(16)));
typedef unsigned u32x2 __attribute__((ext_vector_type(2)));
typedef unsigned u32x4 __attribute__((ext_vector_type(4)));
typedef short s16x4 __attribute__((ext_vector_type(4)));
typedef GAS unsigned gu32;

constexpr int MP = 16384, MS = 1024, M = MP + MS, D = 1024, FF = 3072, SEQ = 4096, TS = 8, NDB = 128;
constexpr float EPS = 1e-6f;
constexpr float LOG2E = 1.4426950408889634f;
constexpr float QSCALE = 0.125f * LOG2E;

constexpr size_t O_Y = 0, O_HP = 17825792, O_CP = 17833984, O_FP = 17858560, O_KP = 17956864, O_VP = 18087936,
                 O_HS = 18219008, O_CS = 18481152, O_FS = 19267584, O_KS = 22413312, O_VS = 26607616, O_END = 30801920;

constexpr size_t MiB = 1u << 20;
constexpr size_t WS_CTL = 0, CTL_ZERO_BYTES = 65536;
constexpr size_t WS_WIN = 2 * MiB;
constexpr size_t WS_WG = 10 * MiB;
constexpr size_t WS_WOUT = 12 * MiB;
constexpr size_t WS_WUP = 16 * MiB;
constexpr size_t WS_WDN = 64 * MiB;
constexpr size_t WS_WKV = 88 * MiB;
constexpr size_t WS_WQ = 89 * MiB;
constexpr size_t WS_WO = 93 * MiB;
constexpr size_t WS_CONST = 97 * MiB;
constexpr size_t WS_SS = 98 * MiB;
constexpr size_t WS_PH = 100 * MiB;
constexpr size_t WS_X16 = 102 * MiB;
constexpr size_t WS_K16 = 136 * MiB, WS_V16 = 144 * MiB;
constexpr size_t WS_KS16 = 152 * MiB, WS_VS16 = 162 * MiB;
constexpr size_t WS_GF = 172 * MiB, WS_VF = 175 * MiB, WS_GL = 178 * MiB;
constexpr size_t WS_XF = WS_GF, WS_XL = WS_VF;
constexpr size_t WS_R1 = 182 * MiB;
constexpr size_t WS_GG = WS_R1, WS_XB = WS_R1 + 34 * MiB, WS_XC = WS_R1 + 68 * MiB, WS_LA = WS_R1 + 102 * MiB, WS_BB = WS_R1 + 136 * MiB;
constexpr size_t WS_Y16 = WS_XB;
constexpr size_t WS_Q16 = WS_R1, WS_O16 = WS_R1 + 34 * MiB;
constexpr size_t WS_H16 = WS_R1;
constexpr size_t WS_END = WS_R1 + 170 * MiB;

constexpr int C_SP2 = 0;
constexpr int C_BIAS2 = 2048;
constexpr int C_SINK2 = 4096;

constexpr int CW_BAR = 4096;

constexpr int RING_BYTES = 131072;
constexpr int LDS_BYTES = 155648;
constexpr int LDSCTL_OFF = LDS_BYTES - 1024, MISC_OFF = LDSCTL_OFF + 320;

__device__ __forceinline__ unsigned pk2h(float lo, float hi) { f32x2 v = {lo, hi}; f16x2 h = __builtin_convertvector(v, f16x2); return __builtin_bit_cast(unsigned, h); }
__device__ __forceinline__ void ld8(const f16* p, float (&o)[8]) { const f16x8 v = *(const f16x8*)p;
#pragma unroll
    for (int i = 0; i < 8; ++i) o[i] = (float)v[i]; }
__device__ __forceinline__ void st16_wt(void* p, u32x4 v) { asm volatile("global_store_dwordx4 %0, %1, off sc1\n\ts_nop 3" :: "v"((GAS unsigned*)p), "v"(v) : "memory"); }
__device__ __forceinline__ void st8w(f16* p, const float (&v)[8]) { u32x4 w; w.x = pk2h(v[0], v[1]); w.y = pk2h(v[2], v[3]); w.z = pk2h(v[4], v[5]); w.w = pk2h(v[6], v[7]); st16_wt(p, w); }
__device__ __forceinline__ void st8(f16* p, const float (&v)[8]) { u32x4 w; w.x = pk2h(v[0], v[1]); w.y = pk2h(v[2], v[3]); w.z = pk2h(v[4], v[5]); w.w = pk2h(v[6], v[7]); *(u32x4*)p = w; }
__device__ __forceinline__ float gelu_t(float x) {
    const float e = __builtin_amdgcn_exp2f(x * (-2.302208198f - 0.10294324f * x * x));
    return x * __builtin_amdgcn_rcpf(1.0f + e);
}
__device__ __forceinline__ float sigmoid_f(float x) { return __builtin_amdgcn_rcpf(1.0f + __builtin_amdgcn_exp2f(-LOG2E * x)); }
template <int CTRL> __device__ __forceinline__ float dppf(float v) { return __builtin_bit_cast(float, __builtin_amdgcn_update_dpp(0, __builtin_bit_cast(int, v), CTRL, 0xf, 0xf, false)); }
#define SHR1 0x111
#define SHR2 0x112
#define SHR4 0x114
#define SHR8 0x118
template <int CTRL> __device__ __forceinline__ float dpp1(float v) { return __builtin_bit_cast(float, __builtin_amdgcn_update_dpp(0x3f800000, __builtin_bit_cast(int, v), CTRL, 0xf, 0xf, false)); }
template <int CTRL> __device__ __forceinline__ float dppz(float v) { return __builtin_bit_cast(float, __builtin_amdgcn_update_dpp(0, __builtin_bit_cast(int, v), CTRL, 0xf, 0xf, true)); }
__device__ __forceinline__ float xor16f(float v) { return __builtin_bit_cast(float, __builtin_amdgcn_ds_swizzle(__builtin_bit_cast(int, v), 0x401F)); }
__device__ __forceinline__ float other32f(float v) { const unsigned u = __builtin_bit_cast(unsigned, v); auto r = __builtin_amdgcn_permlane32_swap(u, u, false, false);
    return __builtin_bit_cast(float, r[0] ^ r[1] ^ u); }
__device__ __forceinline__ float sum16_32(float v) { v += xor16f(v); return v + other32f(v); }
__device__ __forceinline__ float sum8(float v) { v += dppf<0xB1>(v); v += dppf<0x4E>(v); return v + dppf<0x141>(v); }
#define ROR1 0x121
#define ROR2 0x122
#define ROR3 0x123

#ifndef PG8_SP2
#define PG8_SP2 1
#endif
#ifndef PG8_ALIGN
#define PG8_ALIGN 1
#endif
namespace pg8 {
constexpr int BM = 256, BK = 64, HALF = 128, HTB = HALF * BK * 2, STAGE_BYTES = 8 * HTB, NXCD = 8, WGM = 8;
__host__ __device__ __forceinline__ int lds_byte(int r, int c) { const int st = (r >> 4) * 2 + (c >> 5), rr = r & 15, cc = c & 31, ob = rr * 64 + cc * 2; return st * 1024 + (ob ^ (((ob >> 9) & 1) << 5)); }
__host__ __device__ __forceinline__ void stage_rc(int b, int& R, int& C) { const int st = b / 1024, sb = b % 1024, swz = sb ^ (((sb >> 9) & 1) << 5); R = (st >> 1) * 16 + swz / 64; C = (st & 1) * 32 + (swz % 64) / 2; }
__host__ __device__ __forceinline__ int perm32(int rho) { const int n = rho >> 4, i = rho & 15; return 8 * (i >> 2) + 4 * n + (i & 3); }

struct Unit { int pm, pn, idx; };
struct Gemm { const f16* A; const f16* Bt; int M, N, K, lda, amode; };

struct StaticOrder {
    int nM, nN, nwg, G, c; bool lin;
    __device__ __forceinline__ void init(int M_, int N_, int G_, int c_, bool lin_ = false) { nM = M_ / BM; nN = N_ / BM; nwg = nM * nN; G = G_; c = c_; lin = lin_; }
    __device__ __forceinline__ bool next(int i, Unit& u) const {
        u.idx = i;
        const long L = (long)i * G + c; if (L >= nwg) return false;
        if (lin) { u.pm = (int)(L % nM); u.pn = (int)(L / nM); return true; }
        int wgid = (int)L; { const int q = nwg / NXCD, r = nwg % NXCD, xcd = wgid % NXCD, off = wgid / NXCD; wgid = (xcd < r ? xcd * (q + 1) : r * (q + 1) + (xcd - r) * q) + off; }
        const int nig = WGM * nN, gid = wgid / nig, fm = gid * WGM, gsz = (nM - fm) < WGM ? (nM - fm) : WGM;
        u.pm = fm + ((wgid % nig) % gsz); u.pn = (wgid % nig) / gsz; return true;
    }
};

template <class Epi>
__device__ __forceinline__ void gemm_phase(LAS unsigned char* lds, const Gemm g, const StaticOrder& S, const Epi& E, const int tid) {
    const int wid = __builtin_amdgcn_readfirstlane(tid >> 6), lane = tid & 63, wr = wid >> 2, wc = wid & 3, fr = lane & 15, fq = lane >> 4;
    const int K = g.K, nt = K / BK, lda = g.lda;
    unsigned voffA[2], voffB[2];
#pragma unroll
    for (int i = 0; i < 2; ++i) { int R, C; stage_rc(tid * 16 + i * 8192, R, C); const int Rb = Epi::PERM ? ((R & ~31) + perm32(R & 31)) : R;
        const int Ra = (R & ~63) + 4 * (R & 15) + ((R >> 4) & 3);
        voffA[i] = (unsigned)(Ra * lda + C) * 2u; voffB[i] = (unsigned)(Rb * K + C) * 2u; }
    const size_t kstep = (size_t)(BK * 2);
    const size_t hstepA = (size_t)HALF * lda * 2, hstepB = (size_t)HALF * K * 2;
    const size_t tstepA = 2 * hstepA, tstepB = 2 * hstepB;
    const unsigned ldsw = (unsigned)wid * 1024u;
    const int aoff = lds_byte(wr * 64 + fr, fq * 8), boff = lds_byte(wc * 32 + fr, fq * 8);
#define PG8_SA(b, h) (((b) * 2 + (h)) * HTB)
#define PG8_SB(b, h) ((4 + (b) * 2 + (h)) * HTB)
#define PG8_STAGE(bufoff, gbase, voff) do { _Pragma("unroll") for (int _i = 0; _i < 2; ++_i) \
        __builtin_amdgcn_global_load_lds((const unsigned*)((const char*)(gbase) + (voff)[_i]), (LAS unsigned*)(lds + (bufoff) + ldsw + _i * 8192), 16, 0, 0); } while (0)
#define PG8_LDA(dst, b, h) do { _Pragma("unroll") for (int m = 0; m < 4; ++m) _Pragma("unroll") for (int k = 0; k < 2; ++k) dst[m][k] = *(const LAS f16x8*)(lds + PG8_SA(b, h) + aoff + m * 2048 + k * 1024); } while (0)
#define PG8_LDB(dst, b, h) do { _Pragma("unroll") for (int n = 0; n < 2; ++n) _Pragma("unroll") for (int k = 0; k < 2; ++k) dst[n][k] = *(const LAS f16x8*)(lds + PG8_SB(b, h) + boff + n * 2048 + k * 1024); } while (0)
#define PG8_MMA(ai, bj, At, Bt) do { __builtin_amdgcn_s_setprio(1); _Pragma("unroll") for (int m = 0; m < 4; ++m) _Pragma("unroll") for (int n = 0; n < 2; ++n) _Pragma("unroll") for (int k = 0; k < 2; ++k) \
        acc[ai][bj][m][n] = __builtin_amdgcn_mfma_f32_16x16x32_f16(Bt[n][k], At[m][k], acc[ai][bj][m][n], 0, 0, 0); __builtin_amdgcn_s_setprio(0); } while (0)
#define PG8_WAIT_V(n) asm volatile("s_waitcnt vmcnt(" #n ")" ::: "memory")
#define PG8_WAIT_L(n) asm volatile("s_waitcnt lgkmcnt(" #n ")" ::: "memory")
#define PG8_BAR __builtin_amdgcn_s_barrier()
#define PG8_SCHED __builtin_amdgcn_sched_barrier(0)
#define PG8_ACOL(u) ((size_t)(g.amode ? (((u).pn >> 1) * 256 * 2) : 0))
    Unit cur, nxt; int ui = 0;
    if (!S.next(0, cur)) return;
    f32x4 acc[2][2][4][2];
#pragma unroll
    for (int a = 0; a < 2; ++a)
#pragma unroll
        for (int b = 0; b < 2; ++b)
#pragma unroll
            for (int m = 0; m < 4; ++m)
#pragma unroll
                for (int n = 0; n < 2; ++n) acc[a][b][m][n] = (f32x4){0.f, 0.f, 0.f, 0.f};
    f16x8 At[4][2], B0[2][2], B1[2][2];
    const char* cA = (const char*)g.A + (size_t)cur.pm * tstepA + PG8_ACOL(cur); const char* cB = (const char*)g.Bt + (size_t)cur.pn * tstepB;
#if PG8_SP2
    PG8_STAGE(PG8_SB(0, 0), cB, voffB); PG8_STAGE(PG8_SB(0, 1), cB + hstepB, voffB); PG8_STAGE(PG8_SA(0, 0), cA, voffA); PG8_STAGE(PG8_SA(0, 1), cA + hstepA, voffA);
    if (wr == 1) PG8_BAR;
    PG8_WAIT_V(2); PG8_BAR;
    PG8_STAGE(PG8_SB(1, 0), cB + kstep, voffB); PG8_STAGE(PG8_SA(1, 0), cA + kstep, voffA); PG8_STAGE(PG8_SB(1, 1), cB + hstepB + kstep, voffB);
    PG8_WAIT_V(6); PG8_BAR;
#else
    PG8_STAGE(PG8_SB(0, 0), cB, voffB); PG8_STAGE(PG8_SA(0, 0), cA, voffA); PG8_STAGE(PG8_SB(0, 1), cB + hstepB, voffB); PG8_STAGE(PG8_SA(0, 1), cA + hstepA, voffA);
    if (wr == 1) PG8_BAR;
    PG8_WAIT_V(4); PG8_BAR;
    PG8_STAGE(PG8_SB(1, 0), cB + kstep, voffB); PG8_STAGE(PG8_SA(1, 0), cA + kstep, voffA); PG8_STAGE(PG8_SB(1, 1), cB + hstepB + kstep, voffB);
    PG8_WAIT_V(6); PG8_BAR;
#endif
    for (;;) {
        const bool has_next = S.next(ui + 1, nxt);
        const char* nA = has_next ? (const char*)g.A + (size_t)nxt.pm * tstepA + PG8_ACOL(nxt) : cA; const char* nB = has_next ? (const char*)g.Bt + (size_t)nxt.pn * tstepB : cB;
#pragma unroll 1
        for (int t = 0; t < nt; t += 2) {
            const bool last = (t == nt - 2);
            const char* a1 = cA + (size_t)(t + 1) * kstep;
            const char* a2 = last ? nA : cA + (size_t)(t + 2) * kstep; const char* b2 = last ? nB : cB + (size_t)(t + 2) * kstep;
            const char* a3 = a2 + kstep; const char* b3 = b2 + kstep;
#if PG8_SP2
            PG8_LDB(B0, 0, 0); PG8_LDB(B1, 0, 1); PG8_SCHED; PG8_LDA(At, 0, 0); PG8_STAGE(PG8_SA(1, 1), a1 + hstepA, voffA);
            PG8_WAIT_V(8); PG8_WAIT_L(0); PG8_BAR; PG8_MMA(0, 0, At, B0); PG8_MMA(0, 1, At, B1); PG8_BAR; PG8_SCHED;
            PG8_LDA(At, 0, 1); PG8_STAGE(PG8_SB(0, 0), b2, voffB); PG8_STAGE(PG8_SB(0, 1), b2 + hstepB, voffB); PG8_STAGE(PG8_SA(0, 0), a2, voffA);
            PG8_WAIT_V(8); PG8_WAIT_L(0); PG8_BAR; PG8_MMA(1, 0, At, B0); PG8_MMA(1, 1, At, B1); PG8_BAR; PG8_SCHED;
            PG8_LDB(B0, 1, 0); PG8_LDB(B1, 1, 1); PG8_SCHED; PG8_LDA(At, 1, 0); PG8_STAGE(PG8_SA(0, 1), a2 + hstepA, voffA);
            PG8_WAIT_V(8); PG8_WAIT_L(0); PG8_BAR; PG8_MMA(0, 0, At, B0); PG8_MMA(0, 1, At, B1); PG8_BAR; PG8_SCHED;
            PG8_LDA(At, 1, 1); PG8_STAGE(PG8_SB(1, 0), b3, voffB); PG8_STAGE(PG8_SB(1, 1), b3 + hstepB, voffB); PG8_STAGE(PG8_SA(1, 0), a3, voffA);
            PG8_WAIT_V(8); PG8_WAIT_L(0); PG8_BAR; PG8_MMA(1, 0, At, B0); PG8_MMA(1, 1, At, B1); PG8_BAR; PG8_SCHED;
        #else
            PG8_LDB(B0, 0, 0); PG8_SCHED; PG8_LDA(At, 0, 0); PG8_STAGE(PG8_SA(1, 1), a1 + hstepA, voffA);
            PG8_WAIT_L(8); PG8_BAR; PG8_WAIT_L(0); PG8_MMA(0, 0, At, B0); PG8_BAR; PG8_SCHED;
            PG8_LDB(B1, 0, 1); PG8_STAGE(PG8_SB(0, 0), b2, voffB);
            PG8_BAR; PG8_WAIT_L(0); PG8_MMA(0, 1, At, B1); PG8_BAR;
            PG8_LDA(At, 0, 1); PG8_STAGE(PG8_SA(0, 0), a2, voffA);
            PG8_BAR; PG8_WAIT_L(0); PG8_MMA(1, 0, At, B0); PG8_BAR; PG8_SCHED;
            PG8_STAGE(PG8_SB(0, 1), b2 + hstepB, voffB);
            PG8_WAIT_V(6); PG8_BAR; PG8_MMA(1, 1, At, B1); PG8_BAR;
            PG8_LDB(B0, 1, 0); PG8_SCHED; PG8_LDA(At, 1, 0); PG8_STAGE(PG8_SA(0, 1), a2 + hstepA, voffA);
            PG8_WAIT_L(8); PG8_BAR; PG8_WAIT_L(0); PG8_MMA(0, 0, At, B0); PG8_BAR; PG8_SCHED;
            PG8_LDB(B1, 1, 1); PG8_STAGE(PG8_SB(1, 0), b3, voffB);
            PG8_BAR; PG8_WAIT_L(0); PG8_MMA(0, 1, At, B1); PG8_BAR;
            PG8_LDA(At, 1, 1); PG8_STAGE(PG8_SA(1, 0), a3, voffA);
            PG8_BAR; PG8_WAIT_L(0); PG8_MMA(1, 0, At, B0); PG8_BAR; PG8_SCHED;
            PG8_STAGE(PG8_SB(1, 1), b3 + hstepB, voffB);
            PG8_WAIT_V(6); PG8_BAR; PG8_MMA(1, 1, At, B1); PG8_BAR;
#endif
        }
#if PG8_ALIGN
        if (wr == 0) PG8_BAR;
#endif
        { int z_ = 0; asm volatile("" : "+v"(z_));
          const int l2 = (int)__builtin_amdgcn_mbcnt_hi(~0u, __builtin_amdgcn_mbcnt_lo(~0u, (unsigned)z_));
          E(acc, cur, wr, wc, l2 & 15, l2 >> 4); }
        if (!has_next) break;
#pragma unroll
        for (int a = 0; a < 2; ++a)
#pragma unroll
            for (int b = 0; b < 2; ++b)
#pragma unroll
                for (int m = 0; m < 4; ++m)
#pragma unroll
                    for (int n = 0; n < 2; ++n) acc[a][b][m][n] = (f32x4){0.f, 0.f, 0.f, 0.f};
        cur = nxt; cA = nA; cB = nB; ++ui;
#if PG8_ALIGN
        if (wr == 1) PG8_BAR;
#endif
    }
    PG8_WAIT_V(0);
#if !PG8_ALIGN
    if (wr == 0) PG8_BAR;
#endif
    PG8_BAR;
#undef PG8_SA
#undef PG8_SB
#undef PG8_STAGE
#undef PG8_LDA
#undef PG8_LDB
#undef PG8_MMA
#undef PG8_WAIT_V
#undef PG8_WAIT_L
#undef PG8_BAR
#undef PG8_SCHED
#undef PG8_ACOL
}
}
using pg8::Unit;

__device__ __forceinline__ float row_rstd(const float* SS, int row, int fq) {
    const f32x4 s = *(const f32x4*)(SS + (size_t)row * 16 + fq * 4);
    float t = (s.x + s.y) + (s.z + s.w);
    t = sum16_32(t);
    return __builtin_amdgcn_rsqf(t * (1.0f / 1024.0f) + EPS);
}
#define ACC_T const f32x4 (&acc)[2][2][4][2]

__device__ __forceinline__ f16x2 h2(float a, float b) { f32x2 v = {a, b}; return __builtin_convertvector(v, f16x2); }
template <int CTRL> __device__ __forceinline__ f16x2 dpph2(f16x2 v) { return __builtin_bit_cast(f16x2, __builtin_amdgcn_mov_dpp(__builtin_bit_cast(int, v), CTRL, 0xf, 0xf, true)); }
__device__ __forceinline__ f16x2 exp2_h2(f16x2 t) { unsigned r; asm("v_exp_f16_e32 %0, %1\n\ts_nop 0\n\tv_exp_f16_sdwa %0, %1 dst_sel:WORD_1 dst_unused:UNUSED_PRESERVE src0_sel:WORD_1\n\ts_nop 0" : "=&v"(r) : "v"(t)); return __builtin_bit_cast(f16x2, r); }
__device__ __forceinline__ f16x2 rcp_h2(f16x2 t)  { unsigned r; asm("v_rcp_f16_e32 %0, %1\n\ts_nop 0\n\tv_rcp_f16_sdwa %0, %1 dst_sel:WORD_1 dst_unused:UNUSED_PRESERVE src0_sel:WORD_1\n\ts_nop 0" : "=&v"(r) : "v"(t)); return __builtin_bit_cast(f16x2, r); }
__device__ __forceinline__ f16x2 gelu_h2(f16x2 x) {
    const f16x2 c1 = {(f16)-2.302208198f, (f16)-2.302208198f}, c2 = {(f16)-0.10294324f, (f16)-0.10294324f}, one = {(f16)1.0f, (f16)1.0f};
    f16x2 t = x * x; t = t * c2 + c1; t = x * t;
    return x * rcp_h2(exp2_h2(t) + one);
}
#define SB_ __builtin_amdgcn_sched_barrier(0)
__device__ __forceinline__ void gelu4_h2(const f16x2 (&x)[4], f16x2 (&r)[4]) {
    const f16x2 c1 = {(f16)-2.302208198f, (f16)-2.302208198f}, c2 = {(f16)-0.10294324f, (f16)-0.10294324f}, one = {(f16)1.0f, (f16)1.0f};
    f16x2 t[4]; unsigned e[4];
    SB_;
#pragma unroll
    for (int k = 0; k < 4; ++k) t[k] = x[k] * x[k];
    SB_;
#pragma unroll
    for (int k = 0; k < 4; ++k) t[k] = t[k] * c2 + c1;
    SB_;
#pragma unroll
    for (int k = 0; k < 4; ++k) t[k] = x[k] * t[k];
    SB_;
#pragma unroll
    for (int k = 0; k < 4; ++k) asm("v_exp_f16_e32 %0, %1" : "=&v"(e[k]) : "v"(t[k]));
    SB_;
#pragma unroll
    for (int k = 0; k < 4; ++k) asm("v_exp_f16_sdwa %0, %1 dst_sel:WORD_1 dst_unused:UNUSED_PRESERVE src0_sel:WORD_1" : "+v"(e[k]) : "v"(t[k]));
    SB_;
#pragma unroll
    for (int k = 0; k < 4; ++k) t[k] = __builtin_bit_cast(f16x2, e[k]) + one;
    SB_;
#pragma unroll
    for (int k = 0; k < 4; ++k) asm("v_rcp_f16_e32 %0, %1" : "=&v"(e[k]) : "v"(t[k]));
    SB_;
#pragma unroll
    for (int k = 0; k < 4; ++k) asm("v_rcp_f16_sdwa %0, %1 dst_sel:WORD_1 dst_unused:UNUSED_PRESERVE src0_sel:WORD_1" : "+v"(e[k]) : "v"(t[k]));
    SB_;
#pragma unroll
    for (int k = 0; k < 4; ++k) r[k] = x[k] * __builtin_bit_cast(f16x2, e[k]);
    SB_;
}
struct EpiIn {
    static constexpr bool PERM = true;
    const float* SS; f16* GG; f16* XC; f16* XF; f16* XL; const float* cw; const float* cb; float* conv_p;
    __device__ __forceinline__ void operator()(ACC_T, const Unit& u, int wr, int wc, int fr, int fq) const {
        const bool gate = u.pn < 4;
        const int col0 = (u.pn & 3) * 256 + wc * 32 + 8 * fq;
        if (gate) {
            float rsa[2][4];
#pragma unroll
            for (int ai = 0; ai < 2; ++ai)
#pragma unroll
                for (int m = 0; m < 4; ++m) rsa[ai][m] = row_rstd(SS, u.pm * 256 + ai * 128 + wr * 64 + 4 * fr + m, fq);
#pragma unroll
            for (int ai = 0; ai < 2; ++ai)
#pragma unroll
                for (int m = 0; m < 4; ++m) {
                    const int row = u.pm * 256 + ai * 128 + wr * 64 + 4 * fr + m;
                    const f16x2 rs2 = h2(rsa[ai][m], rsa[ai][m]);
#pragma unroll
                    for (int bj = 0; bj < 2; ++bj) {
                        u32x4 w; f16x2 xg[4], yg[4];
#pragma unroll
                        for (int j = 0; j < 4; ++j) xg[j] = h2(acc[ai][bj][m][j >> 1][2 * (j & 1)], acc[ai][bj][m][j >> 1][2 * (j & 1) + 1]) * rs2;
                        gelu4_h2(xg, yg);
#pragma unroll
                        for (int j = 0; j < 4; ++j) w[j] = __builtin_bit_cast(unsigned, yg[j]);
                        st16_wt(GG + (size_t)row * 1024 + col0 + bj * 128, w);
                    }
                }
        } else {
#pragma unroll
            for (int bj = 0; bj < 2; ++bj) {
                const int col = col0 + bj * 128;
                f16x2 w0[4], w1[4], w2[4], w3[4], b0[4];
#pragma unroll
                for (int j = 0; j < 4; ++j) { w0[j] = h2(cw[col + 2 * j], cw[col + 2 * j + 1]); w1[j] = h2(cw[1024 + col + 2 * j], cw[1024 + col + 2 * j + 1]); w2[j] = h2(cw[2048 + col + 2 * j], cw[2048 + col + 2 * j + 1]);
                                              w3[j] = h2(cw[3072 + col + 2 * j], cw[3072 + col + 2 * j + 1]); b0[j] = h2(cb[col + 2 * j], cb[col + 2 * j + 1]); }
#pragma unroll
                for (int ai = 0; ai < 2; ++ai) {
                    const int cidx = u.pm * 4 + ai * 2 + wr, rowb = u.pm * 256 + ai * 128 + wr * 64 + 4 * fr;
                    float rs4[4];
#pragma unroll
                    for (int m = 0; m < 4; ++m) rs4[m] = row_rstd(SS, rowb + m, fq);
                    f16x2 x[4][4];
#pragma unroll
                    for (int m = 0; m < 4; ++m) { const f16x2 rs2 = h2(rs4[m], rs4[m]);
#pragma unroll
                        for (int j = 0; j < 4; ++j) x[m][j] = h2(acc[ai][bj][m][j >> 1][2 * (j & 1)], acc[ai][bj][m][j >> 1][2 * (j & 1) + 1]) * rs2; }
                    u32x4 xc[4];
#pragma unroll
                    for (int j = 0; j < 4; ++j) {
                        const f16x2 p3 = dpph2<SHR1>(x[3][j]), p2 = dpph2<SHR1>(x[2][j]), p1 = dpph2<SHR1>(x[1][j]);
                        xc[0][j] = __builtin_bit_cast(unsigned, b0[j] + w0[j] * p1 + w1[j] * p2 + w2[j] * p3 + w3[j] * x[0][j]);
                        xc[1][j] = __builtin_bit_cast(unsigned, b0[j] + w0[j] * p2 + w1[j] * p3 + w2[j] * x[0][j] + w3[j] * x[1][j]);
                        xc[2][j] = __builtin_bit_cast(unsigned, b0[j] + w0[j] * p3 + w1[j] * x[0][j] + w2[j] * x[1][j] + w3[j] * x[2][j]);
                        xc[3][j] = __builtin_bit_cast(unsigned, b0[j] + w0[j] * x[0][j] + w1[j] * x[1][j] + w2[j] * x[2][j] + w3[j] * x[3][j]);
                    }
#pragma unroll
                    for (int m = 0; m < 4; ++m) {
                        st16_wt(XC + (size_t)(rowb + m) * 1024 + col, xc[m]);
#define XR_ (u32x4){__builtin_bit_cast(unsigned, x[m][0]), __builtin_bit_cast(unsigned, x[m][1]), __builtin_bit_cast(unsigned, x[m][2]), __builtin_bit_cast(unsigned, x[m][3])}
                        if (m < 3 && fr == 0) *(u32x4*)(XF + ((size_t)cidx * 3 + m) * 1024 + col) = XR_;
                        if (m >= 1 && fr == 15) {
                            *(u32x4*)(XL + ((size_t)cidx * 3 + (m - 1)) * 1024 + col) = XR_;
                            const int t = (rowb + m) & 4095;
                            if (t >= 4093) { float* dst = conv_p + ((size_t)((rowb + m) >> 12) * 3 + (t - 4093)) * 1024 + col; *(f32x4*)dst = acc[ai][bj][m][0] * rs4[m]; *(f32x4*)(dst + 4) = acc[ai][bj][m][1] * rs4[m]; }
                        }
#undef XR_
                    }
                }
            }
        }
    }
};

__device__ __forceinline__ void gate_ab(float ar, float ai_, float cbr, float cbi, float csp, float xc, float& a, float& b) {
    const float r = __builtin_amdgcn_rcpf(1.0f + __builtin_amdgcn_exp2f(ar * -LOG2E + cbr)), ig = __builtin_amdgcn_rcpf(1.0f + __builtin_amdgcn_exp2f(ai_ * -LOG2E + cbi));
    a = __builtin_amdgcn_exp2f(-r * csp);
    b = __builtin_amdgcn_sqrtf(__builtin_fmaf(-a, a, 1.0f)) * ig * xc;
}
constexpr int GL_TOT = 131072, GL_AGL = GL_TOT + 4096, GL_CAR = GL_AGL + 16384;
constexpr int CW_GFLAG = 8192;
__device__ __forceinline__ unsigned flag_ld(unsigned* p) { return __hip_atomic_load(p, __ATOMIC_RELAXED, __HIP_MEMORY_SCOPE_AGENT); }
struct EpiGate {
    static constexpr bool PERM = true;
    const f16* XC; const f16* GG; f16* Y; float* AGG; unsigned* FLG; float* hp; const float* br; const float* bi; const float* sp2; LAS unsigned char* lds;
    __device__ __forceinline__ void operator()(const f32x4 (&acc)[2][2][4][2], const Unit& u, int wr, int wc, int fr, int fq) const {
        const int cl = 32 * wc + 8 * fq, ch0 = 128 * u.pn + cl;
        const f16* xcp = XC + (size_t)(u.pm * 256 + wr * 64 + 4 * fr) * 1024 + ch0;
        LAS float* TOT = (LAS float*)(lds + GL_TOT);
        u32x2 hlp[2][2][4], acp[2][2][4];
        u32x2 xhi[2][4];
        f32x4 cq[2][3];
#pragma unroll
        for (int n = 0; n < 2; ++n) { cq[n][0] = *(const f32x4*)(br + ch0 + 4 * n); cq[n][1] = *(const f32x4*)(bi + ch0 + 4 * n); cq[n][2] = *(const f32x4*)(sp2 + ch0 + 4 * n); }
#pragma unroll
        for (int n = 0; n < 2; ++n) {
            float cbr[4], cbi[4], csp[4];
#pragma unroll
            for (int j = 0; j < 4; ++j) { cbr[j] = cq[n][0][j] * -LOG2E; cbi[j] = cq[n][1][j] * -LOG2E; csp[j] = cq[n][2][j]; }
#pragma unroll
            for (int ai = 0; ai < 2; ++ai) {
                float a[4][4], b[4][4];
#pragma unroll
                for (int m = 0; m < 4; ++m) {
                    f16x4 xc;
                    if (n == 0) { const u32x4 x8 = *(const u32x4*)(xcp + (size_t)(ai * 128 + m) * 1024); xc = __builtin_bit_cast(f16x4, (u32x2){x8.x, x8.y}); xhi[ai][m] = (u32x2){x8.z, x8.w}; }
                    else xc = __builtin_bit_cast(f16x4, xhi[ai][m]);
#pragma unroll
                    for (int j = 0; j < 4; ++j) gate_ab(acc[ai][0][m][n][j], acc[ai][1][m][n][j], cbr[j], cbi[j], csp[j], (float)xc[j], a[m][j], b[m][j]);
                }
#pragma unroll
                for (int m = 1; m < 4; ++m)
#pragma unroll
                    for (int j = 0; j < 4; ++j) { b[m][j] = a[m][j] * b[m - 1][j] + b[m][j]; a[m][j] = a[m][j] * a[m - 1][j]; }
                float A[4], B[4];
#pragma unroll
                for (int j = 0; j < 4; ++j) { A[j] = a[3][j]; B[j] = b[3][j]; }
#define SCAN_STEP(CTRL, D) _Pragma("unroll") for (int j = 0; j < 4; ++j) { const float ap = dpp1<CTRL>(A[j]), bp = dppz<CTRL>(B[j]); B[j] = A[j] * bp + B[j]; A[j] = A[j] * ap; }
                SCAN_STEP(SHR1, 1) SCAN_STEP(SHR2, 2) SCAN_STEP(SHR4, 4) SCAN_STEP(SHR8, 8)
#undef SCAN_STEP
                float Ae[4], Be[4];
#pragma unroll
                for (int j = 0; j < 4; ++j) { Ae[j] = dpp1<SHR1>(A[j]); Be[j] = dppz<SHR1>(B[j]); }
#pragma unroll
                for (int m = 0; m < 4; ++m) {
                    hlp[n][ai][m] = (u32x2){pk2h(a[m][0] * Be[0] + b[m][0], a[m][1] * Be[1] + b[m][1]), pk2h(a[m][2] * Be[2] + b[m][2], a[m][3] * Be[3] + b[m][3])};
                    acp[n][ai][m] = (u32x2){pk2h(a[m][0] * Ae[0], a[m][1] * Ae[1]), pk2h(a[m][2] * Ae[2], a[m][3] * Ae[3])};
                    asm volatile("" : "+v"(hlp[n][ai][m]), "+v"(acp[n][ai][m]));
                }
                if (fr == 15) {
                    LAS float* t = TOT + ((ai * 2 + wr) * 128 + cl + 4 * n) * 2;
                    *(LAS f32x4*)t = (f32x4){A[0], B[0], A[1], B[1]}; *(LAS f32x4*)(t + 4) = (f32x4){A[2], B[2], A[3], B[3]};
                }
            }
            __builtin_amdgcn_sched_barrier(0);
        }
        asm volatile("" ::: "memory");
        int frg = fr; asm volatile("" : "+v"(frg));
        const int wid = wr * 4 + wc, lane = fq * 16 + fr, tid = wid * 64 + lane, sp = u.pm & 15;
        u32x4 ggv[2][4];
#define GG_LOAD_ _Pragma("unroll") for (int ai = 0; ai < 2; ++ai) _Pragma("unroll") for (int m = 0; m < 4; ++m) \
            ggv[ai][m] = *(const u32x4*)(GG + (size_t)(u.pm * 256 + ai * 128 + wr * 64 + 4 * frg + m) * 1024 + 128 * u.pn + 32 * wc + 8 * (frg - fr + fq));
        if (wid != 0) { GG_LOAD_ }
        asm volatile("s_waitcnt lgkmcnt(0)" ::: "memory"); __builtin_amdgcn_s_barrier(); asm volatile("" ::: "memory");
        float* aggb = AGG + (size_t)(u.pn * 64) * 256;
        unsigned* flg = FLG + u.pn * 64;
#define PQ_PRE_ _Pragma("unroll") for (int ai = 0; ai < 2; ++ai) _Pragma("unroll") for (int m = 0; m < 4; ++m) { const u32x4 gw = ggv[ai][m]; _Pragma("unroll") for (int n = 0; n < 2; ++n) { \
            const unsigned h0_ = hlp[n][ai][m][0], h1_ = hlp[n][ai][m][1], a0_ = acp[n][ai][m][0], a1_ = acp[n][ai][m][1], g0_ = gw[2 * n], g1_ = gw[2 * n + 1]; \
            const f16x2 gg0 = __builtin_bit_cast(f16x2, g0_), gg1 = __builtin_bit_cast(f16x2, g1_); \
            hlp[n][ai][m] = (u32x2){__builtin_bit_cast(unsigned, __builtin_bit_cast(f16x2, h0_) * gg0), __builtin_bit_cast(unsigned, __builtin_bit_cast(f16x2, h1_) * gg1)}; \
            acp[n][ai][m] = (u32x2){__builtin_bit_cast(unsigned, __builtin_bit_cast(f16x2, a0_) * gg0), __builtin_bit_cast(unsigned, __builtin_bit_cast(f16x2, a1_) * gg1)}; } }
        if (wid != 0) { PQ_PRE_ }
        if (wid == 0) {
#pragma unroll
            for (int hh = 0; hh < 2; ++hh) {
                const int c = lane + 64 * hh; float P = 1.f, H = 0.f;
#pragma unroll
                for (int k = 0; k < 4; ++k) { const f32x2 t = *(const LAS f32x2*)(TOT + (k * 128 + c) * 2); H = t.x * H + t.y; P *= t.x; }
                __hip_atomic_store((GAS unsigned long long*)(aggb + (size_t)u.pm * 256 + 2 * c), ((unsigned long long)__builtin_bit_cast(unsigned, H) << 32) | __builtin_bit_cast(unsigned, P), __ATOMIC_RELAXED, __HIP_MEMORY_SCOPE_AGENT);
            }
            asm volatile("s_waitcnt vmcnt(0)" ::: "memory");
            if (lane == 0) __hip_atomic_store(flg + u.pm, 1u, __ATOMIC_RELAXED, __HIP_MEMORY_SCOPE_AGENT);
            GG_LOAD_
            if (lane < sp) { unsigned* f = flg + u.pm - 1 - lane; unsigned spn = 0; while (flag_ld(f) == 0u) { __builtin_amdgcn_s_sleep(1); if (++spn > (1u << 20)) break; } }
            __builtin_amdgcn_fence(__ATOMIC_ACQUIRE, "agent");
            asm volatile("s_waitcnt vmcnt(0)" ::: "memory");
            PQ_PRE_
        }
        asm volatile("" ::: "memory"); __builtin_amdgcn_s_barrier(); asm volatile("" ::: "memory");
        {   LAS float* AGL = (LAS float*)(lds + GL_AGL);
            for (int it = tid; it < sp * 64; it += 512) { const int k = 1 + (it >> 6), q = it & 63;
                const f32x4 v = *(const f32x4*)(aggb + (size_t)(u.pm - k) * 256 + q * 4); *(LAS f32x4*)(AGL + k * 256 + q * 4) = v; }
        }
        asm volatile("s_waitcnt vmcnt(0) lgkmcnt(0)" ::: "memory"); __builtin_amdgcn_s_barrier(); asm volatile("" ::: "memory");
        if (tid < 128) {
            const LAS float* AGL = (const LAS float*)(lds + GL_AGL); LAS float* CAR = (LAS float*)(lds + GL_CAR);
            float carry = 0.f;
            for (int k = sp; k >= 1; --k) { const f32x2 t = *(const LAS f32x2*)(AGL + k * 256 + 2 * tid); carry = t.x * carry + t.y; }
#pragma unroll
            for (int k = 0; k < 4; ++k) { CAR[k * 128 + tid] = carry; const f32x2 t = *(const LAS f32x2*)(TOT + (k * 128 + tid) * 2); carry = t.x * carry + t.y; }
            if (sp == 15) hp[(size_t)(u.pm >> 4) * 1024 + 128 * u.pn + tid] = carry;
        }
        asm volatile("s_waitcnt lgkmcnt(0)" ::: "memory"); __builtin_amdgcn_s_barrier(); asm volatile("" ::: "memory");
        int fry = fr; asm volatile("" : "+v"(fry));
#pragma unroll
        for (int ai = 0; ai < 2; ++ai) {
            const LAS float* cp = (const LAS float*)(lds + GL_CAR) + (ai * 2 + wr) * 128 + cl;
            const f32x4 c0 = *(const LAS f32x4*)cp, c1 = *(const LAS f32x4*)(cp + 4);
            const f16x2 cpk[4] = {h2(c0[0], c0[1]), h2(c0[2], c0[3]), h2(c1[0], c1[1]), h2(c1[2], c1[3])};
#pragma unroll
            for (int m = 0; m < 4; ++m) {
                const int row = u.pm * 256 + ai * 128 + wr * 64 + 4 * fry + m;
                u32x4 o;
#pragma unroll
                for (int n = 0; n < 2; ++n)
#pragma unroll
                    for (int k = 0; k < 2; ++k) {
                        const unsigned h_ = hlp[n][ai][m][k], a_ = acp[n][ai][m][k];
                        o[2 * n + k] = __builtin_bit_cast(unsigned, __builtin_bit_cast(f16x2, h_) + __builtin_bit_cast(f16x2, a_) * cpk[2 * n + k]);
                    }
                st16_wt(Y + (size_t)row * 1024 + 128 * u.pn + 32 * wc + 8 * (fry - fr + fq), o);
            }
        }
    }
};

#undef PQ_PRE_
#undef GG_LOAD_
struct EpiRes {
    static constexpr bool PERM = true;
    const float* xin;
    float* yout;
    f16* X16; float* SS; const float* bias; bool dry;
    __device__ __forceinline__ void fin(const f32x4 (&acc)[2][2][4][2], const f32x4 (&bv)[2][2], const f32x4& x0, const f32x4& x1, int ai, int bj, int m, int row, int col, float& ss) const {
        const f32x4 v0 = x0 + acc[ai][bj][m][0] + bv[bj][0], v1 = x1 + acc[ai][bj][m][1] + bv[bj][1];
        u32x4 h; h.x = pk2h(v0[0], v0[1]); h.y = pk2h(v0[2], v0[3]); h.z = pk2h(v1[0], v1[1]); h.w = pk2h(v1[2], v1[3]);
        if (!dry && !yout) st16_wt(X16 + (size_t)row * 1024 + col, h);
        if (yout) { float* y = yout + (size_t)row * 1024 + col; *(f32x4*)y = v0; *(f32x4*)(y + 4) = v1; }
        ss += ((v0[0] * v0[0] + v0[1] * v0[1]) + (v0[2] * v0[2] + v0[3] * v0[3])) + ((v1[0] * v1[0] + v1[1] * v1[1]) + (v1[2] * v1[2] + v1[3] * v1[3]));
    }
    __device__ __forceinline__ void operator()(const f32x4 (&acc)[2][2][4][2], const Unit& u, int wr, int wc, int fr, int fq) const {
        const int col0 = u.pn * 256 + wc * 32 + 8 * fq;
        f32x4 bv[2][2];
#pragma unroll
        for (int bj = 0; bj < 2; ++bj)
#pragma unroll
            for (int n = 0; n < 2; ++n) bv[bj][n] = bias ? *(const f32x4*)(bias + col0 + bj * 128 + n * 4) : (f32x4){0.f, 0.f, 0.f, 0.f};
        f16x8 xa[2][4][2];
#pragma unroll
        for (int ai = 0; ai < 2; ++ai)
#pragma unroll
            for (int m = 0; m < 4; ++m)
#pragma unroll
                for (int bj = 0; bj < 2; ++bj) xa[ai][m][bj] = *(const f16x8*)(X16 + (size_t)(u.pm * 256 + ai * 128 + wr * 64 + 4 * fr + m) * 1024 + col0 + bj * 128);
        asm volatile("" ::: "memory");
#pragma unroll
        for (int ai = 0; ai < 2; ++ai) {
            const int rowb = u.pm * 256 + ai * 128 + wr * 64 + 4 * fr;
#pragma unroll
            for (int m = 0; m < 4; ++m) { float ss = 0.f;
#pragma unroll
                for (int bj = 0; bj < 2; ++bj) { const f16x8 q = xa[ai][m][bj]; const f32x4 x0 = {(float)q[0], (float)q[1], (float)q[2], (float)q[3]}, x1 = {(float)q[4], (float)q[5], (float)q[6], (float)q[7]};
                    fin(acc, bv, x0, x1, ai, bj, m, rowb + m, col0 + bj * 128, ss); }
                ss = sum16_32(ss);
                if (fq == 0 && !dry && !yout) SS[(size_t)(rowb + m) * 16 + u.pn * 4 + wc] = ss; }
        }
    }
};

__device__ __forceinline__ float rstd_row(const float* SS, int row);
constexpr int UPC_CONST = 131072, UPC_RSTD = UPC_CONST + 8192, UPC_MAXT = 8;
__device__ __forceinline__ bool up_preload(LAS unsigned char* lds, const pg8::StaticOrder& S, const float* SS, const float* cw, const float* cb, int tid) {
    pg8::Unit uu;
    float cv[UPC_MAXT]; f32x4 sv[4][4]; bool okc[UPC_MAXT], okr[4];
    const int arr = tid >> 7, c = tid & 127;
#pragma unroll
    for (int i = 0; i < UPC_MAXT; ++i) { okc[i] = S.next(i, uu); if (okc[i]) { const int ch = 128 * uu.pn + c; cv[i] = arr == 0 ? cb[ch] : cw[(arr - 1) * FF + ch]; } }
#pragma unroll
    for (int k = 0; k < 4; ++k) { const int e = tid + 512 * k, i = e >> 8; okr[k] = S.next(i, uu);
        if (okr[k]) { const f32x4* p = (const f32x4*)(SS + (size_t)(uu.pm * 256 + (e & 255)) * 16); sv[k][0] = p[0]; sv[k][1] = p[1]; sv[k][2] = p[2]; sv[k][3] = p[3]; } }
#pragma unroll
    for (int i = 0; i < UPC_MAXT; ++i) if (okc[i]) ((LAS f16*)(lds + UPC_CONST + i * 1024))[arr * 128 + c] = (f16)cv[i];
#pragma unroll
    for (int k = 0; k < 4; ++k) if (okr[k]) { const int e = tid + 512 * k; const f32x4 a = sv[k][0], b = sv[k][1], cc = sv[k][2], d = sv[k][3];
        const float t = ((a.x + a.y) + (a.z + a.w)) + ((b.x + b.y) + (b.z + b.w)) + ((cc.x + cc.y) + (cc.z + cc.w)) + ((d.x + d.y) + (d.z + d.w));
        ((LAS float*)(lds + UPC_RSTD + (e >> 8) * 1024))[e & 255] = __builtin_amdgcn_rsqf(t * (1.0f / 1024.0f) + EPS); }
    const bool fits = !S.next(UPC_MAXT, uu);
    __syncthreads();
    return fits;
}
struct EpiUp {
    static constexpr bool PERM = true;
    const float* SS; f16* H; f16* GF; f16* VF; f16* GL; const float* cw; const float* cb; const float* st; float* fp; float* fs; LAS unsigned char* lds; bool pre;
    __device__ __forceinline__ void operator()(const f32x4 (&acc)[2][2][4][2], const Unit& u, int wr, int wc, int fr, int fq) const {
        const int ch0 = 128 * u.pn + 32 * wc + 8 * fq;
        f16x2 w0[4], w1[4], w2[4], b0[4];
        if (pre) {
            const LAS unsigned char* cl = lds + UPC_CONST + u.idx * 1024 + (32 * wc + 8 * fq) * 2;
            const u32x4 q0 = *(const LAS u32x4*)cl, q1 = *(const LAS u32x4*)(cl + 256), q2 = *(const LAS u32x4*)(cl + 512), q3 = *(const LAS u32x4*)(cl + 768);
#pragma unroll
            for (int j = 0; j < 4; ++j) { const unsigned a_ = q0[j], b_ = q1[j], c_ = q2[j], d_ = q3[j];
                b0[j] = __builtin_bit_cast(f16x2, a_); w0[j] = __builtin_bit_cast(f16x2, b_); w1[j] = __builtin_bit_cast(f16x2, c_); w2[j] = __builtin_bit_cast(f16x2, d_); }
        } else {
#pragma unroll
            for (int j = 0; j < 4; ++j) { w0[j] = h2(cw[ch0 + 2 * j], cw[ch0 + 2 * j + 1]); w1[j] = h2(cw[FF + ch0 + 2 * j], cw[FF + ch0 + 2 * j + 1]);
                                          w2[j] = h2(cw[2 * FF + ch0 + 2 * j], cw[2 * FF + ch0 + 2 * j + 1]); b0[j] = h2(cb[ch0 + 2 * j], cb[ch0 + 2 * j + 1]); }
        }
#pragma unroll
        for (int ai = 0; ai < 2; ++ai) {
            const int cidx = u.pm * 4 + ai * 2 + wr, rowb = u.pm * 256 + ai * 128 + wr * 64 + 4 * fr;
            float rsa[4];
            if (pre) { const f32x4 r4 = *(const LAS f32x4*)(lds + UPC_RSTD + u.idx * 1024 + (ai * 128 + wr * 64 + 4 * fr) * 4); rsa[0] = r4[0]; rsa[1] = r4[1]; rsa[2] = r4[2]; rsa[3] = r4[3]; }
            else {
#pragma unroll
                for (int m = 0; m < 4; ++m) rsa[m] = row_rstd(SS, rowb + m, fq);
            }
            f16x2 g[4][4], v[4][4];
#pragma unroll
            for (int m = 0; m < 4; ++m) { const f16x2 rs2 = h2(rsa[m], rsa[m]);
#pragma unroll
                for (int j = 0; j < 4; ++j) { g[m][j] = h2(acc[ai][0][m][j >> 1][2 * (j & 1)], acc[ai][0][m][j >> 1][2 * (j & 1) + 1]) * rs2;
                                              v[m][j] = h2(acc[ai][1][m][j >> 1][2 * (j & 1)], acc[ai][1][m][j >> 1][2 * (j & 1) + 1]) * rs2; } }
            u32x4 hw[4];
#pragma unroll
            for (int j = 0; j < 4; ++j) {
                const f16x2 p3 = dpph2<SHR1>(g[3][j]), p2 = dpph2<SHR1>(g[2][j]);
                const f16x2 gc[4] = {b0[j] + w0[j] * p2 + w1[j] * p3 + w2[j] * g[0][j], b0[j] + w0[j] * p3 + w1[j] * g[0][j] + w2[j] * g[1][j],
                                     b0[j] + w0[j] * g[0][j] + w1[j] * g[1][j] + w2[j] * g[2][j], b0[j] + w0[j] * g[1][j] + w1[j] * g[2][j] + w2[j] * g[3][j]};
                f16x2 ge[4]; gelu4_h2(gc, ge);
#pragma unroll
                for (int m = 0; m < 4; ++m) hw[m][j] = __builtin_bit_cast(unsigned, ge[m] * v[m][j]);
            }
#pragma unroll
            for (int m = 0; m < 4; ++m) {
                st16_wt(H + (size_t)(rowb + m) * FF + ch0, hw[m]);
#define GR_ (u32x4){__builtin_bit_cast(unsigned, g[m][0]), __builtin_bit_cast(unsigned, g[m][1]), __builtin_bit_cast(unsigned, g[m][2]), __builtin_bit_cast(unsigned, g[m][3])}
                if (m < 2 && fr == 0) {
                    *(u32x4*)(GF + ((size_t)cidx * 2 + m) * FF + ch0) = GR_;
                    *(u32x4*)(VF + ((size_t)cidx * 2 + m) * FF + ch0) = (u32x4){__builtin_bit_cast(unsigned, v[m][0]), __builtin_bit_cast(unsigned, v[m][1]), __builtin_bit_cast(unsigned, v[m][2]), __builtin_bit_cast(unsigned, v[m][3])};
                }
                if (m >= 2 && fr == 15) {
                    *(u32x4*)(GL + ((size_t)cidx * 2 + (m - 2)) * FF + ch0) = GR_;
                    const int t = (rowb + m) & 4095;
                    if (t >= 4094) { float* dst = fp + ((size_t)((rowb + m) >> 12) * 2 + (t - 4094)) * FF + ch0;
                        *(f32x4*)dst = acc[ai][0][m][0] * rsa[m]; *(f32x4*)(dst + 4) = acc[ai][0][m][1] * rsa[m]; }
                }
#undef GR_
            }
        }
    }
};

struct EpiKV {
    static constexpr bool PERM = true;
    const float* SS; const float* bkv; const float* knorm; f16* K16; f16* V16; f16* KS16; f16* VS16; float* out;
    __device__ __forceinline__ void operator()(ACC_T, const Unit& u, int wr, int wc, int fr, int fq) const {
        const bool isv = u.pn == 1;
        f32x4 bv[2][2], gn[2][2];
#pragma unroll
        for (int bj = 0; bj < 2; ++bj)
#pragma unroll
            for (int n = 0; n < 2; ++n) { const int d = 32 * bj + 8 * fq + 4 * n; bv[bj][n] = *(const f32x4*)(bkv + u.pn * 256 + 64 * wc + d); gn[bj][n] = *(const f32x4*)(knorm + d); }
        float rsa[2][4];
#pragma unroll
        for (int ai = 0; ai < 2; ++ai)
#pragma unroll
            for (int m = 0; m < 4; ++m) rsa[ai][m] = row_rstd(SS, u.pm * 256 + ai * 128 + wr * 64 + 4 * fr + m, fq);
#pragma unroll
        for (int ai = 0; ai < 2; ++ai)
#pragma unroll
            for (int m = 0; m < 4; ++m) {
                const int row = u.pm * 256 + ai * 128 + wr * 64 + 4 * fr + m;
                const float rs = rsa[ai][m];
                f32x4 v[2][2]; float ss = 0.f;
#pragma unroll
                for (int bj = 0; bj < 2; ++bj)
#pragma unroll
                    for (int n = 0; n < 2; ++n) { v[bj][n] = acc[ai][bj][m][n] * rs + bv[bj][n]; const f32x4 q = v[bj][n]; ss += (q[0] * q[0] + q[1] * q[1]) + (q[2] * q[2] + q[3] * q[3]); }
                ss = sum16_32(ss);
                const float ri = __builtin_amdgcn_rsqf(ss * (1.0f / 64.0f) + EPS);
                f16* d16 = (isv ? V16 : K16) + (size_t)row * 256 + 64 * wc; float* d32 = nullptr;
                { const int t = row & 4095; if (t >= 3968) d32 = out + (isv ? O_VP : O_KP) + ((size_t)(row >> 12) * 128 + (t - 3968)) * 256 + 64 * wc; }
#pragma unroll
                for (int bj = 0; bj < 2; ++bj) {
                    const int d = 32 * bj + 8 * fq;
                    f32x4 o0 = v[bj][0], o1 = v[bj][1]; if (!isv) { o0 = o0 * ri * gn[bj][0]; o1 = o1 * ri * gn[bj][1]; }
                    u32x4 h; h.x = pk2h(o0[0], o0[1]); h.y = pk2h(o0[2], o0[3]); h.z = pk2h(o1[0], o1[1]); h.w = pk2h(o1[2], o1[3]);
                    st16_wt(d16 + d, h);
                    if (d32) { *(f32x4*)(d32 + d) = o0; *(f32x4*)(d32 + d + 4) = o1; }
                }
            }
    }
};

struct EpiQ {
    static constexpr bool PERM = true;
    const float* SS; const float* bq; const float* qnorm; f16* Q16;
    __device__ __forceinline__ void operator()(ACC_T, const Unit& u, int wr, int wc, int fr, int fq) const {
        f32x4 bv[2][2], gn[2][2];
        const int hc = u.pn * 256 + 64 * wc;
#pragma unroll
        for (int bj = 0; bj < 2; ++bj)
#pragma unroll
            for (int n = 0; n < 2; ++n) { const int d = 32 * bj + 8 * fq + 4 * n; bv[bj][n] = *(const f32x4*)(bq + hc + d); gn[bj][n] = *(const f32x4*)(qnorm + d) * QSCALE; }
        float rsa[2][4];
#pragma unroll
        for (int ai = 0; ai < 2; ++ai)
#pragma unroll
            for (int m = 0; m < 4; ++m) rsa[ai][m] = row_rstd(SS, u.pm * 256 + ai * 128 + wr * 64 + 4 * fr + m, fq);
#pragma unroll
        for (int ai = 0; ai < 2; ++ai)
#pragma unroll
            for (int m = 0; m < 4; ++m) {
                const int row = u.pm * 256 + ai * 128 + wr * 64 + 4 * fr + m;
                const float rs = rsa[ai][m];
                f32x4 v[2][2]; float ss = 0.f;
#pragma unroll
                for (int bj = 0; bj < 2; ++bj)
#pragma unroll
                    for (int n = 0; n < 2; ++n) { v[bj][n] = acc[ai][bj][m][n] * rs + bv[bj][n]; const f32x4 q = v[bj][n]; ss += (q[0] * q[0] + q[1] * q[1]) + (q[2] * q[2] + q[3] * q[3]); }
                ss = sum16_32(ss);
                const float ri = __builtin_amdgcn_rsqf(ss * (1.0f / 64.0f) + EPS);
#pragma unroll
                for (int bj = 0; bj < 2; ++bj) {
                    const int d = 32 * bj + 8 * fq;
                    const f32x4 o0 = v[bj][0] * ri * gn[bj][0], o1 = v[bj][1] * ri * gn[bj][1];
                    u32x4 h; h.x = pk2h(o0[0], o0[1]); h.y = pk2h(o0[2], o0[3]); h.z = pk2h(o1[0], o1[1]); h.w = pk2h(o1[2], o1[3]);
                    st16_wt(Q16 + (size_t)row * 1024 + hc + d, h);
                }
            }
    }
};
#undef ACC_T


__device__ __forceinline__ float rstd_row(const float* SS, int row) {
    const f32x4* p = (const f32x4*)(SS + (size_t)row * 16);
    const f32x4 a = p[0], b = p[1], c = p[2], d = p[3];
    const float t = ((a.x + a.y) + (a.z + a.w)) + ((b.x + b.y) + (b.z + b.w)) + ((c.x + c.y) + (c.z + c.w)) + ((d.x + d.y) + (d.z + d.w));
    return __builtin_amdgcn_rsqf(t * (1.0f / 1024.0f) + EPS);
}
namespace sg {
constexpr int TST = 68;
constexpr int PT_BYTES = 64 * TST * 4;
struct SGemm { const f16* A; int lda; const f16* Bt; int K; };
template <class EPI>
__device__ __forceinline__ void stile_finish(LAS unsigned char* lds, const f32x4 (&acc)[4][4], const EPI& E, int rt, int ct, int wave, const f32x4 (&ssr)[4]) {
    int z_ = 0; asm volatile("" : "+v"(z_));
    const int lane_ = (int)__builtin_amdgcn_mbcnt_hi(~0u, __builtin_amdgcn_mbcnt_lo(~0u, (unsigned)z_)), tid = wave * 64 + lane_, fr = lane_ & 15, fq = lane_ >> 4;
    LAS float* P = (LAS float*)(lds + wave * PT_BYTES);
#pragma unroll
    for (int mb = 0; mb < 4; ++mb)
#pragma unroll
        for (int nb = 0; nb < 4; ++nb) *(LAS f32x4*)(P + (16 * mb + fr) * TST + 16 * nb + 4 * fq) = acc[mb][nb];
    __syncthreads();
    {   const int r = tid >> 3, c8 = (tid & 7) * 8;
        LAS float* T0 = (LAS float*)lds + r * TST + c8;
        f32x4 s0 = *(LAS f32x4*)T0, s1 = *(LAS f32x4*)(T0 + 4);
#pragma unroll
        for (int w = 1; w < 8; ++w) { const LAS float* Tw = (const LAS float*)(lds + w * PT_BYTES) + r * TST + c8; s0 += *(const LAS f32x4*)Tw; s1 += *(const LAS f32x4*)(Tw + 4); }
        if constexpr (EPI::ROWSCALE) {
            const f32x4 a = ssr[0], b = ssr[1], c = ssr[2], d = ssr[3];
            const float t = ((a.x + a.y) + (a.z + a.w)) + ((b.x + b.y) + (b.z + b.w)) + ((c.x + c.y) + (c.z + c.w)) + ((d.x + d.y) + (d.z + d.w));
            const float rs = __builtin_amdgcn_rsqf(t * (1.0f / 1024.0f) + EPS); s0 = s0 * rs; s1 = s1 * rs; }
        *(LAS f32x4*)T0 = s0; *(LAS f32x4*)(T0 + 4) = s1;
    }
    __syncthreads();
    E.tile((LAS float*)lds, rt, ct, tid, ssr);
    __syncthreads();
}
template <int NSTEP, class EPI>
__device__ __forceinline__ void sgemm_phase(LAS unsigned char* lds, const SGemm g, const int nct, const EPI& E, const int vcu, const int G, const int tid) {
    const int lane = tid & 63, wave = __builtin_amdgcn_readfirstlane(tid >> 6), fr = lane & 15, fq = lane >> 4;
    constexpr int kw = NSTEP * 32;
    const int nunits = 16 * nct;
    if constexpr (NSTEP == 4) {
        int su = vcu; if (su >= nunits) return;
        f16x8 af[4][4], bf[4][4]; int rt_have = -1;
        {   const int ct = su >> 4;
#pragma unroll
            for (int nb = 0; nb < 4; ++nb) { const f16* Bb = g.Bt + (size_t)(E.brow(ct, nb) + fr) * g.K + wave * kw + 8 * fq;
#pragma unroll
                for (int s = 0; s < 4; ++s) bf[s][nb] = *(const f16x8*)(Bb + 32 * s); } }
        for (; su < nunits; su += G) {
            const int rt = su & 15, ct = su >> 4;
            if (rt != rt_have) { rt_have = rt; const f16* Ab = g.A + (size_t)(MP + 64 * rt + fr) * g.lda + E.acol(ct) + wave * kw + 8 * fq;
#pragma unroll
                for (int mb = 0; mb < 4; ++mb)
#pragma unroll
                    for (int s = 0; s < 4; ++s) af[s][mb] = *(const f16x8*)(Ab + (size_t)mb * 16 * g.lda + 32 * s); }
            f32x4 acc[4][4];
#pragma unroll
            for (int a = 0; a < 4; ++a)
#pragma unroll
                for (int b = 0; b < 4; ++b) acc[a][b] = (f32x4){0.f, 0.f, 0.f, 0.f};
#pragma unroll
            for (int s = 0; s < 4; ++s)
#pragma unroll
                for (int mb = 0; mb < 4; ++mb)
#pragma unroll
                    for (int nb = 0; nb < 4; ++nb) acc[mb][nb] = __builtin_amdgcn_mfma_f32_16x16x32_f16(bf[s][nb], af[s][mb], acc[mb][nb], 0, 0, 0);
            if (su + G < nunits) { const int ctn = (su + G) >> 4;
#pragma unroll
                for (int nb = 0; nb < 4; ++nb) { const f16* Bb = g.Bt + (size_t)(E.brow(ctn, nb) + fr) * g.K + wave * kw + 8 * fq;
#pragma unroll
                    for (int s = 0; s < 4; ++s) bf[s][nb] = *(const f16x8*)(Bb + 32 * s); } }
            { f32x4 ssr[4] = {}; E.head(rt, ct, tid, ssr); stile_finish(lds, acc, E, rt, ct, wave, ssr); }
        }
    } else {
        constexpr int CH = NSTEP >= 2 ? 2 : 1, NCH = NSTEP / CH;
        for (int su = vcu; su < nunits; su += G) {
            const int rt = su & 15, ct = su >> 4;
            f32x4 acc[4][4];
#pragma unroll
            for (int a = 0; a < 4; ++a)
#pragma unroll
                for (int b = 0; b < 4; ++b) acc[a][b] = (f32x4){0.f, 0.f, 0.f, 0.f};
            const f16* Ab = g.A + (size_t)(MP + 64 * rt + fr) * g.lda + E.acol(ct) + wave * kw + 8 * fq;
            const f16* Bb[4];
#pragma unroll
            for (int nb = 0; nb < 4; ++nb) Bb[nb] = g.Bt + (size_t)(E.brow(ct, nb) + fr) * g.K + wave * kw + 8 * fq;
            f16x8 a0[CH][4], b0[CH][4], a1[CH][4], b1[CH][4];
#define SG_LOAD(A_, B_, c) do { _Pragma("unroll") for (int s = 0; s < CH; ++s) { _Pragma("unroll") for (int mb = 0; mb < 4; ++mb) A_[s][mb] = *(const f16x8*)(Ab + (size_t)mb * 16 * g.lda + 32 * ((c) * CH + s)); \
                _Pragma("unroll") for (int nb = 0; nb < 4; ++nb) B_[s][nb] = *(const f16x8*)(Bb[nb] + 32 * ((c) * CH + s)); } } while (0)
#define SG_MMA(A_, B_) do { _Pragma("unroll") for (int s = 0; s < CH; ++s) _Pragma("unroll") for (int mb = 0; mb < 4; ++mb) _Pragma("unroll") for (int nb = 0; nb < 4; ++nb) \
                acc[mb][nb] = __builtin_amdgcn_mfma_f32_16x16x32_f16(B_[s][nb], A_[s][mb], acc[mb][nb], 0, 0, 0); } while (0)
            SG_LOAD(a0, b0, 0);
            if constexpr (NCH == 1) { SG_MMA(a0, b0); }
            else {
#pragma unroll 1
                for (int c = 0; c < NCH; c += 2) {
                    SG_LOAD(a1, b1, c + 1);
                    SG_MMA(a0, b0);
                    if (c + 2 < NCH) SG_LOAD(a0, b0, c + 2);
                    SG_MMA(a1, b1);
                }
            }
#undef SG_LOAD
#undef SG_MMA
            { f32x4 ssr[4] = {}; E.head(rt, ct, tid, ssr); stile_finish(lds, acc, E, rt, ct, wave, ssr); }
        }
    }
}
template <class EPI>
__device__ __forceinline__ void sgemm_staged(LAS unsigned char* lds, const SGemm g, const int nct, const EPI& E, const int vcu, const int G, const int tid) {
    const int lane = tid & 63, wave = __builtin_amdgcn_readfirstlane(tid >> 6), fr = lane & 15, fq = lane >> 4;
    const int nunits = 16 * nct, nch = g.K >> 8;
    int R, C; pg8::stage_rc(tid * 16, R, C);
    const unsigned ldsw = (unsigned)wave * 1024u;
    const int rdoff = (wave >> 1) * 8192 + pg8::lds_byte(fr, 32 * (wave & 1) + 8 * fq);
    for (int su = vcu; su < nunits; su += G) {
        const int rt = su & 15, ct = su >> 4;
        const char* Ap = (const char*)(g.A + (size_t)(MP + 64 * rt + R) * g.lda + E.acol(ct) + C);
        const char* Bp = (const char*)(g.Bt + (size_t)(E.brow(ct, R >> 4) + (R & 15)) * g.K + C);
        f32x4 ssr[4] = {};
        E.head(rt, ct, tid, ssr);
#define SGS_STAGE(buf, kc) do { _Pragma("unroll") for (int s_ = 0; s_ < 4; ++s_) { \
            __builtin_amdgcn_global_load_lds((const unsigned*)(Ap + (size_t)(kc) * 512 + s_ * 128), (LAS unsigned*)(lds + (buf) * 65536 + s_ * 8192 + ldsw), 16, 0, 0); \
            __builtin_amdgcn_global_load_lds((const unsigned*)(Bp + (size_t)(kc) * 512 + s_ * 128), (LAS unsigned*)(lds + (buf) * 65536 + 32768 + s_ * 8192 + ldsw), 16, 0, 0); } } while (0)
        f32x4 acc[4][4];
#pragma unroll
        for (int a = 0; a < 4; ++a)
#pragma unroll
            for (int b = 0; b < 4; ++b) acc[a][b] = (f32x4){0.f, 0.f, 0.f, 0.f};
        SGS_STAGE(0, 0); if (nch > 1) SGS_STAGE(1, 1);
#pragma unroll 1
        for (int kc = 0; kc < nch; ++kc) {
            const int buf = kc & 1;
            if (kc + 1 < nch) asm volatile("s_waitcnt vmcnt(8)" ::: "memory"); else asm volatile("s_waitcnt vmcnt(0)" ::: "memory");
            __builtin_amdgcn_s_barrier(); asm volatile("" ::: "memory");
            f16x8 af[4], bf[4];
#pragma unroll
            for (int mb = 0; mb < 4; ++mb) af[mb] = *(const LAS f16x8*)(lds + buf * 65536 + rdoff + mb * 2048);
#pragma unroll
            for (int nb = 0; nb < 4; ++nb) bf[nb] = *(const LAS f16x8*)(lds + buf * 65536 + 32768 + rdoff + nb * 2048);
            asm volatile("s_waitcnt lgkmcnt(0)" ::: "memory");
            __builtin_amdgcn_s_barrier(); asm volatile("" ::: "memory");
            if (kc + 2 < nch) SGS_STAGE(buf, kc + 2);
            __builtin_amdgcn_sched_barrier(0);
#pragma unroll
            for (int mb = 0; mb < 4; ++mb)
#pragma unroll
                for (int nb = 0; nb < 4; ++nb) acc[mb][nb] = __builtin_amdgcn_mfma_f32_16x16x32_f16(bf[nb], af[mb], acc[mb][nb], 0, 0, 0);
        }
#undef SGS_STAGE
        stile_finish(lds, acc, E, rt, ct, wave, ssr);
    }
}
}

__device__ __forceinline__ void head_ss(const float* SS, int rt, int tid, f32x4 (&hd)[4]) { const f32x4* p = (const f32x4*)(SS + (size_t)(MP + 64 * rt + (tid >> 3)) * 16); hd[0] = p[0]; hd[1] = p[1]; hd[2] = p[2]; hd[3] = p[3]; }
#define STILE(r, c) T[(r) * sg::TST + (c)]
struct SEpiIn {
    static constexpr bool ROWSCALE = true;
    const float* SS; f16* GG; f16* XC; const float* cw; const float* cb; const float* st  ; float* conv_s;
    __device__ __forceinline__ int acol(int) const { return 0; }
    __device__ __forceinline__ int brow(int ct, int nb) const { return 64 * ct + 16 * nb; }
    __device__ __forceinline__ void head(int rt, int ct, int tid, f32x4 (&hd)[4]) const { head_ss(SS, rt, tid, hd); }
    __device__ __forceinline__ void tile(LAS float* T, int rt, int ct, int tid, const f32x4 (&hdat)[4]) const {
        const int r = tid >> 3, c8 = (tid & 7) * 8, row = MP + 64 * rt + r;
        float v[8];
#pragma unroll
        for (int i = 0; i < 8; ++i) v[i] = STILE(r, c8 + i);
        if (ct < 16) {
#pragma unroll
            for (int i = 0; i < 8; ++i) v[i] = gelu_t(v[i]);
            st8w(GG + (size_t)row * 1024 + 64 * ct + c8, v);
        } else {
            const int col = 64 * (ct - 16) + c8, t = row & 7, db = (row - MP) >> 3;
            float o[8];
#pragma unroll
            for (int i = 0; i < 8; ++i) {
                float acc_ = cb[col + i] + cw[3072 + col + i] * v[i];
#pragma unroll
                for (int k = 1; k <= 3; ++k) { const float xk = t >= k ? STILE(t >= k ? r - k : r, c8 + i) : st[((size_t)db * 3 + (3 + t - k)) * 1024 + col + i]; acc_ += cw[(3 - k) * 1024 + col + i] * xk; }
                o[i] = acc_;
            }
            st8w(XC + (size_t)row * 1024 + col, o);
            if (t >= 5) { float* dst = conv_s + ((size_t)db * 3 + (t - 5)) * 1024 + col; *(f32x4*)dst = (f32x4){v[0], v[1], v[2], v[3]}; *(f32x4*)(dst + 4) = (f32x4){v[4], v[5], v[6], v[7]}; }
        }
    }
};
struct SEpiGate {
    static constexpr bool ROWSCALE = false; const float* SS = nullptr;
    const f16* XC; const f16* GG; f16* Y; const float* hst  ; float* hs  ; const float* br; const float* bi; const float* sp2;
    __device__ __forceinline__ int acol(int ct) const { return (ct >> 3) * 256; }
    __device__ __forceinline__ int brow(int ct, int nb) const { return 256 * (ct >> 2) + 32 * (ct & 3) + 16 * (nb & 1) + 128 * (nb >> 1); }
    __device__ __forceinline__ void head(int, int, int, f32x4 (&)[4]) const {}
    __device__ __forceinline__ void tile(LAS float* T, int rt, int ct, int tid, const f32x4 (&hdat)[4]) const {
        const int r = tid >> 3, c4 = (tid & 7) * 4, row = MP + 64 * rt + r, ch = 32 * ct + c4;
        const f16x4 xc = *(const f16x4*)(XC + (size_t)row * 1024 + ch);
#pragma unroll
        for (int j = 0; j < 4; ++j) { float a, b; gate_ab(STILE(r, c4 + j), STILE(r, 32 + c4 + j), br[ch + j] * -LOG2E, bi[ch + j] * -LOG2E, sp2[ch + j], (float)xc[j], a, b); STILE(r, c4 + j) = a; STILE(r, 32 + c4 + j) = b; }
        __syncthreads();
        const int t = r & 7, db = (row - MP) >> 3;
        const f32x4 h0 = *(const f32x4*)(hst + (size_t)db * 1024 + ch);
        const f16x4 gg = *(const f16x4*)(GG + (size_t)row * 1024 + ch);
        float y[4], hf[4];
#pragma unroll
        for (int j = 0; j < 4; ++j) { float h = h0[j];
            for (int s = 0; s <= t; ++s) { const float a = STILE(r - t + s, c4 + j), b = STILE(r - t + s, 32 + c4 + j); h = a * h + b; }
            hf[j] = h; y[j] = (float)gg[j] * h; }
        u32x2 x; x.x = pk2h(y[0], y[1]); x.y = pk2h(y[2], y[3]); *(u32x2*)(Y + (size_t)row * 1024 + ch) = x;
        if (t == 7) *(f32x4*)(hs + (size_t)db * 1024 + ch) = (f32x4){hf[0], hf[1], hf[2], hf[3]};
    }
};
struct SEpiRes {
    static constexpr bool ROWSCALE = false;
    const float* xin;
    float* yout;
    f16* X16; float* SS; const float* bias; bool dry;
    __device__ __forceinline__ int acol(int) const { return 0; }
    __device__ __forceinline__ int brow(int ct, int nb) const { return 64 * ct + 16 * nb; }
    __device__ __forceinline__ void head(int rt, int ct, int tid, f32x4 (&hd)[4]) const {
        const int row = MP + 64 * rt + (tid >> 3), col = 64 * ct + (tid & 7) * 8;
        hd[0] = __builtin_bit_cast(f32x4, *(const u32x4*)(X16 + (size_t)row * 1024 + col));
        if (bias) { hd[1] = *(const f32x4*)(bias + col); hd[2] = *(const f32x4*)(bias + col + 4); } else { hd[1] = (f32x4){0.f, 0.f, 0.f, 0.f}; hd[2] = hd[1]; }
    }
    __device__ __forceinline__ void tile(LAS float* T, int rt, int ct, int tid, const f32x4 (&hdat)[4]) const {
        const int r = tid >> 3, c8 = (tid & 7) * 8, row = MP + 64 * rt + r, col = 64 * ct + c8;
        const f16x8 xr = __builtin_bit_cast(f16x8, hdat[0]);
        float v[8]; float ss = 0.f;
#pragma unroll
        for (int i = 0; i < 8; ++i) { v[i] = STILE(r, c8 + i) + (float)xr[i] + (i < 4 ? hdat[1][i & 3] : hdat[2][i & 3]); ss += v[i] * v[i]; }
        if (yout) { float* xd = yout + (size_t)(row - MP) * 1024 + col; *(f32x4*)xd = (f32x4){v[0], v[1], v[2], v[3]}; *(f32x4*)(xd + 4) = (f32x4){v[4], v[5], v[6], v[7]}; }
        ss = sum8(ss);
        if (!dry && !yout) { st8w(X16 + (size_t)row * 1024 + col, v); if ((tid & 7) == 0) SS[(size_t)row * 16 + ct] = ss; }
    }
};
struct SEpiUp {
    static constexpr bool ROWSCALE = true;
    const float* SS; f16* H; const float* cw; const float* cb; const float* st; float* fs;
    __device__ __forceinline__ int acol(int) const { return 0; }
    __device__ __forceinline__ int brow(int ct, int nb) const { return 256 * (ct >> 2) + 32 * (ct & 3) + 16 * (nb & 1) + 128 * (nb >> 1); }
    __device__ __forceinline__ void head(int rt, int ct, int tid, f32x4 (&hd)[4]) const { head_ss(SS, rt, tid, hd); }
    __device__ __forceinline__ void tile(LAS float* T, int rt, int ct, int tid, const f32x4 (&hdat)[4]) const {
        const int r = tid >> 3, c4 = (tid & 7) * 4, row = MP + 64 * rt + r, t = r & 7, db = (64 * rt + r) >> 3, ch = 128 * (ct >> 2) + 32 * (ct & 3) + c4;
        float h[4], g0[4];
#pragma unroll
        for (int j = 0; j < 4; ++j) {
            g0[j] = STILE(r, c4 + j); const float vv = STILE(r, 32 + c4 + j);
            const float s1 = st[((size_t)db * 2 + 1) * FF + ch + j], s0 = st[((size_t)db * 2) * FF + ch + j];
            const float gm1 = t >= 1 ? STILE(t >= 1 ? r - 1 : r, c4 + j) : s1;
            const float gm2 = t >= 2 ? STILE(t >= 2 ? r - 2 : r, c4 + j) : (t == 1 ? s1 : s0);
            const float gc = cb[ch + j] + cw[ch + j] * gm2 + cw[FF + ch + j] * gm1 + cw[2 * FF + ch + j] * g0[j];
            h[j] = gelu_t(gc) * vv;
        }
        u32x2 a; a.x = pk2h(h[0], h[1]); a.y = pk2h(h[2], h[3]); *(u32x2*)(H + (size_t)row * FF + ch) = a;
        if (t >= 6) *(f32x4*)(fs + ((size_t)db * 2 + (t - 6)) * FF + ch) = (f32x4){g0[0], g0[1], g0[2], g0[3]};
    }
};
struct SEpiKV {
    static constexpr bool ROWSCALE = true;
    const float* SS; const float* bkv; const float* knorm; f16* KS16; f16* VS16; float* out;
    __device__ __forceinline__ int acol(int) const { return 0; }
    __device__ __forceinline__ int brow(int ct, int nb) const { return 256 * (ct >> 2) + 128 * (nb >> 1) + 32 * (ct & 3) + 16 * (nb & 1); }
    __device__ __forceinline__ void head(int rt, int ct, int tid, f32x4 (&hd)[4]) const { head_ss(SS, rt, tid, hd); }
    __device__ __forceinline__ void tile(LAS float* T, int rt, int ct, int tid, const f32x4 (&hdat)[4]) const {
        const int r = tid >> 3, c8 = (tid & 7) * 8, row = MP + 64 * rt + r; const bool isv = ct >= 4; const int hd = ct & 3;
        float v[8]; float ss = 0.f;
#pragma unroll
        for (int i = 0; i < 8; ++i) { v[i] = STILE(r, c8 + i) + bkv[64 * ct + c8 + i]; ss += v[i] * v[i]; }
        ss = sum8(ss);
        if (!isv) { const float ri = __builtin_amdgcn_rsqf(ss * (1.0f / 64.0f) + EPS);
#pragma unroll
            for (int i = 0; i < 8; ++i) v[i] = v[i] * ri * knorm[c8 + i]; }
        const int db = (row - MP) >> 3, t = row & 7;
        st8w((isv ? VS16 : KS16) + ((size_t)db * 160 + 128 + t) * 256 + 64 * hd + c8, v);
        float* d32 = out + (isv ? O_VS : O_KS) + ((size_t)db * 128 + 120 + t) * 256 + 64 * hd + c8;
        *(f32x4*)d32 = (f32x4){v[0], v[1], v[2], v[3]}; *(f32x4*)(d32 + 4) = (f32x4){v[4], v[5], v[6], v[7]};
    }
};
struct SEpiQ {
    static constexpr bool ROWSCALE = true;
    const float* SS; const float* bq; const float* qnorm; f16* Q16;
    __device__ __forceinline__ int acol(int) const { return 0; }
    __device__ __forceinline__ int brow(int ct, int nb) const { return 256 * (ct >> 2) + 128 * (nb >> 1) + 32 * (ct & 3) + 16 * (nb & 1); }
    __device__ __forceinline__ void head(int rt, int ct, int tid, f32x4 (&hd)[4]) const { head_ss(SS, rt, tid, hd); }
    __device__ __forceinline__ void tile(LAS float* T, int rt, int ct, int tid, const f32x4 (&hdat)[4]) const {
        const int r = tid >> 3, c8 = (tid & 7) * 8, row = MP + 64 * rt + r;
        float v[8]; float ss = 0.f;
#pragma unroll
        for (int i = 0; i < 8; ++i) { v[i] = STILE(r, c8 + i) + bq[64 * ct + c8 + i]; ss += v[i] * v[i]; }
        ss = sum8(ss);
        const float ri = __builtin_amdgcn_rsqf(ss * (1.0f / 64.0f) + EPS) * QSCALE;
#pragma unroll
        for (int i = 0; i < 8; ++i) v[i] = v[i] * ri * qnorm[c8 + i];
        st8w(Q16 + (size_t)row * 1024 + 64 * ct + c8, v);
    }
};
#undef STILE

struct EpiNull {
    static constexpr bool PERM = true; float* sink;
    __device__ __forceinline__ void operator()(const f32x4 (&acc)[2][2][4][2], const Unit& u, int wr, int wc, int fr, int fq) const {
        float s = 0.f;
#pragma unroll
        for (int ai = 0; ai < 2; ++ai)
#pragma unroll
            for (int bj = 0; bj < 2; ++bj)
#pragma unroll
                for (int m = 0; m < 4; ++m)
#pragma unroll
                    for (int n = 0; n < 2; ++n) s += (acc[ai][bj][m][n][0] + acc[ai][bj][m][n][1]) + (acc[ai][bj][m][n][2] + acc[ai][bj][m][n][3]);
        if (s == 123.456f) sink[fr] = s;
    }
};
struct EpiKVQ {
    static constexpr bool PERM = true; EpiKV kv; EpiQ q;
    __device__ __forceinline__ void operator()(const f32x4 (&acc)[2][2][4][2], const Unit& u, int wr, int wc, int fr, int fq) const {
        if (u.pn < 2) kv(acc, u, wr, wc, fr, fq); else { const Unit u2{u.pm, u.pn - 2}; q(acc, u2, wr, wc, fr, fq); }
    }
};
struct SEpiKVQ {
    static constexpr bool ROWSCALE = true; SEpiKV kv; SEpiQ q; const float* SS;
    __device__ __forceinline__ int acol(int) const { return 0; }
    __device__ __forceinline__ int brow(int ct, int nb) const { return 256 * (ct >> 2) + 128 * (nb >> 1) + 32 * (ct & 3) + 16 * (nb & 1); }
    __device__ __forceinline__ void head(int rt, int ct, int tid, f32x4 (&hd)[4]) const { head_ss(SS, rt, tid, hd); }
    __device__ __forceinline__ void tile(LAS float* T, int rt, int ct, int tid, const f32x4 (&hdat)[4]) const { if (ct < 8) kv.tile(T, rt, ct, tid, hdat); else q.tile(T, rt, ct - 8, tid, hdat); }
};

__device__ __forceinline__ void sup_phase(LAS unsigned char* lds, const f16* X16, const f16* Wt, const float* SS, f16* H, const float* cw, const float* cb, const float* st, float* fs,
                                          const int vcu, const int G, const int tid) {
    if (vcu >= 8 * 24) return;
    const int lane = tid & 63, wave = __builtin_amdgcn_readfirstlane(tid >> 6), fr = lane & 15, fq = lane >> 4;
    constexpr int SA = 0, SB = 49152, SBUF_A = 16384, SBUF_B = 32768;
    unsigned voffA[2], voffB[4];
    { int R, C;
#pragma unroll
      for (int i = 0; i < 2; ++i) { pg8::stage_rc(tid * 16 + i * 8192, R, C); voffA[i] = (unsigned)(R * 1024 + C) * 2u; }
#pragma unroll
      for (int p = 0; p < 4; ++p) { pg8::stage_rc(tid * 16 + (p & 1) * 8192, R, C); const int rho = 128 * (p >> 1) + R;
          voffB[p] = (unsigned)((128 * ((rho >> 4) & 1) + 16 * (rho >> 5) + (rho & 15)) * 1024 + C) * 2u; } }
    const unsigned ldsw = (unsigned)wave * 1024u;
    const int aoff = pg8::lds_byte(fr, fq * 8), boff = (wave >> 2) * 16384 + pg8::lds_byte((wave & 3) * 32 + fr, fq * 8);
#define SUP_STAGE(buf, kc) do { \
        _Pragma("unroll") for (int i_ = 0; i_ < 2; ++i_) __builtin_amdgcn_global_load_lds((const unsigned*)(Ag + voffA[i_] + (size_t)(kc) * 128), (LAS unsigned*)(lds + SA + (buf) * SBUF_A + i_ * 8192 + ldsw), 16, 0, 0); \
        _Pragma("unroll") for (int p_ = 0; p_ < 4; ++p_) __builtin_amdgcn_global_load_lds((const unsigned*)(Bgp + voffB[p_] + (size_t)(kc) * 128), (LAS unsigned*)(lds + SB + (buf) * SBUF_B + p_ * 8192 + ldsw), 16, 0, 0); } while (0)
    for (int su = vcu; su < 8 * 24; su += G) {
        const int rt = su & 7, ct = su >> 3;
        const char* Ag = (const char*)(X16 + (size_t)(MP + 128 * rt) * 1024); const char* Bgp = (const char*)(Wt + (size_t)(256 * ct) * 1024);
        const int c0 = 128 * ct + 16 * wave + 4 * fq, t = fr & 7;
        SUP_STAGE(0, 0); SUP_STAGE(1, 1);
        float rs[8];
#pragma unroll
        for (int mb = 0; mb < 8; ++mb) rs[mb] = row_rstd(SS, MP + 128 * rt + 16 * mb + fr, fq);
        const f32x4 w0 = *(const f32x4*)(cw + c0), w1 = *(const f32x4*)(cw + FF + c0), w2 = *(const f32x4*)(cw + 2 * FF + c0), b0 = *(const f32x4*)(cb + c0);
        f32x4 acc[2][8];
#pragma unroll
        for (int a = 0; a < 2; ++a)
#pragma unroll
            for (int b = 0; b < 8; ++b) acc[a][b] = (f32x4){0.f, 0.f, 0.f, 0.f};
        int buf = 0;
#pragma unroll 1
        for (int kc = 0; kc < 16; ++kc) {
            if (kc + 1 < 16) asm volatile("s_waitcnt vmcnt(6)" ::: "memory"); else asm volatile("s_waitcnt vmcnt(0)" ::: "memory");
            __builtin_amdgcn_s_barrier(); asm volatile("" ::: "memory");
            if (kc + 2 < 16) { const int b2 = buf == 0 ? 2 : buf - 1; SUP_STAGE(b2, kc + 2); }
            f16x8 bf[2][2];
#pragma unroll
            for (int n = 0; n < 2; ++n)
#pragma unroll
                for (int k = 0; k < 2; ++k) bf[n][k] = *(const LAS f16x8*)(lds + SB + buf * SBUF_B + boff + n * 2048 + k * 1024);
#pragma unroll
            for (int hm = 0; hm < 2; ++hm) {
                f16x8 af[4][2];
#pragma unroll
                for (int mb = 0; mb < 4; ++mb)
#pragma unroll
                    for (int k = 0; k < 2; ++k) af[mb][k] = *(const LAS f16x8*)(lds + SA + buf * SBUF_A + aoff + (4 * hm + mb) * 2048 + k * 1024);
                asm volatile("s_waitcnt lgkmcnt(0)" ::: "memory");
                __builtin_amdgcn_sched_barrier(0);
#pragma unroll
                for (int mb = 0; mb < 4; ++mb)
#pragma unroll
                    for (int n = 0; n < 2; ++n)
#pragma unroll
                        for (int k = 0; k < 2; ++k) acc[n][4 * hm + mb] = __builtin_amdgcn_mfma_f32_16x16x32_f16(bf[n][k], af[mb][k], acc[n][4 * hm + mb], 0, 0, 0);
                __builtin_amdgcn_sched_barrier(0);
            }
            buf = buf == 2 ? 0 : buf + 1;
        }
        __builtin_amdgcn_s_barrier(); asm volatile("" ::: "memory");
        f32x4 s1a[8], s0a[8];
#pragma unroll
        for (int mb = 0; mb < 8; ++mb) { const int db = (128 * rt + 16 * mb + fr) >> 3; const int tt = t < 2 ? 1 : 0;
            s1a[mb] = *(const f32x4*)(st + ((size_t)db * 2 + tt) * FF + c0); s0a[mb] = *(const f32x4*)(st + ((size_t)db * 2) * FF + c0); }
#pragma unroll
        for (int mb = 0; mb < 8; ++mb) {
            const int rl = 128 * rt + 16 * mb + fr, db = rl >> 3; const size_t row = (size_t)MP + rl;
            const f32x4 g = acc[0][mb] * rs[mb], v = acc[1][mb] * rs[mb];
            const f32x4 s1 = s1a[mb], s0 = s0a[mb];
            float h[4];
#pragma unroll
            for (int j = 0; j < 4; ++j) {
                const float p1 = dppz<SHR1>(g[j]), p2 = dppz<SHR2>(g[j]);
                const float gm1 = t >= 1 ? p1 : s1[j], gm2 = t >= 2 ? p2 : (t == 1 ? s1[j] : s0[j]);
                const float gc = b0[j] + w0[j] * gm2 + w1[j] * gm1 + w2[j] * g[j];
                h[j] = gelu_t(gc) * v[j];
            }
            u32x2 o; o.x = pk2h(h[0], h[1]); o.y = pk2h(h[2], h[3]);
            *(u32x2*)(H + row * FF + c0) = o;
            if (t >= 6) *(f32x4*)(fs + ((size_t)db * 2 + (t - 6)) * FF + c0) = g;
        }
    }
#undef SUP_STAGE
}

__device__ __forceinline__ void sup_phase96(LAS unsigned char* lds, const f16* X16, const f16* Wt, const float* SS, f16* H, const float* cw, const float* cb, const float* st, float* fs,
                                          const int vcu, const int G, const int tid) {
    if (vcu >= 8 * 32) return;
    const int lane = tid & 63, wave = __builtin_amdgcn_readfirstlane(tid >> 6), fr = lane & 15, fq = lane >> 4;
    constexpr int SA = 0, SB = 49152, SBUF_A = 16384, SBUF_B = 32768;
    unsigned voffA[2], voffB[3];
    { int R, C;
#pragma unroll
      for (int i = 0; i < 2; ++i) { pg8::stage_rc(tid * 16 + i * 8192, R, C); voffA[i] = (unsigned)(R * 1024 + C) * 2u; }
    }
    const unsigned ldsw = (unsigned)wave * 1024u;
    const int aoff = pg8::lds_byte(fr, fq * 8), boff = (wave >> 2) * 16384 + pg8::lds_byte((wave & 3) * 32 + fr, fq * 8);
#define SUP_STAGE(buf, kc) do { \
        _Pragma("unroll") for (int i_ = 0; i_ < 2; ++i_) __builtin_amdgcn_global_load_lds((const unsigned*)(Ag + voffA[i_] + (size_t)(kc) * 128), (LAS unsigned*)(lds + SA + (buf) * SBUF_A + i_ * 8192 + ldsw), 16, 0, 0); \
        _Pragma("unroll") for (int p_ = 0; p_ < 3; ++p_) __builtin_amdgcn_global_load_lds((const unsigned*)(Bgp + voffB[p_] + (size_t)(kc) * 128), (LAS unsigned*)(lds + SB + (buf) * SBUF_B + p_ * 8192 + ldsw), 16, 0, 0); } while (0)
    for (int su = vcu; su < 8 * 32; su += G) {
        const int rt = su & 7, ct = su >> 3;
        const char* Ag = (const char*)(X16 + (size_t)(MP + 128 * rt) * 1024); const char* Bgp = (const char*)Wt;
        { int R, C;
#pragma unroll
          for (int p = 0; p < 3; ++p) { pg8::stage_rc(tid * 16 + (p & 1) * 8192, R, C); const int rho = 128 * (p >> 1) + R;
              const int ch = 96 * ct + 16 * (rho >> 5) + (rho & 15);
              voffB[p] = (unsigned)((256 * (ch >> 7) + 128 * ((rho >> 4) & 1) + (ch & 127)) * 1024 + C) * 2u; } }
        const int c0 = 96 * ct + 16 * wave + 4 * fq, t = fr & 7;
        SUP_STAGE(0, 0); SUP_STAGE(1, 1);
        float rs[8];
#pragma unroll
        for (int mb = 0; mb < 8; ++mb) rs[mb] = row_rstd(SS, MP + 128 * rt + 16 * mb + fr, fq);
        const f32x4 w0 = *(const f32x4*)(cw + c0), w1 = *(const f32x4*)(cw + FF + c0), w2 = *(const f32x4*)(cw + 2 * FF + c0), b0 = *(const f32x4*)(cb + c0);
        f32x4 acc[2][8];
#pragma unroll
        for (int a = 0; a < 2; ++a)
#pragma unroll
            for (int b = 0; b < 8; ++b) acc[a][b] = (f32x4){0.f, 0.f, 0.f, 0.f};
        int buf = 0;
#pragma unroll 1
        for (int kc = 0; kc < 16; ++kc) {
            if (kc + 1 < 16) asm volatile("s_waitcnt vmcnt(5)" ::: "memory"); else asm volatile("s_waitcnt vmcnt(0)" ::: "memory");
            __builtin_amdgcn_s_barrier(); asm volatile("" ::: "memory");
            if (kc + 2 < 16) { const int b2 = buf == 0 ? 2 : buf - 1; SUP_STAGE(b2, kc + 2); }
            if (wave < 6) {
            f16x8 bf[2][2];
#pragma unroll
            for (int n = 0; n < 2; ++n)
#pragma unroll
                for (int k = 0; k < 2; ++k) bf[n][k] = *(const LAS f16x8*)(lds + SB + buf * SBUF_B + boff + n * 2048 + k * 1024);
#pragma unroll
            for (int hm = 0; hm < 2; ++hm) {
                f16x8 af[4][2];
#pragma unroll
                for (int mb = 0; mb < 4; ++mb)
#pragma unroll
                    for (int k = 0; k < 2; ++k) af[mb][k] = *(const LAS f16x8*)(lds + SA + buf * SBUF_A + aoff + (4 * hm + mb) * 2048 + k * 1024);
                asm volatile("s_waitcnt lgkmcnt(0)" ::: "memory");
                __builtin_amdgcn_sched_barrier(0);
#pragma unroll
                for (int mb = 0; mb < 4; ++mb)
#pragma unroll
                    for (int n = 0; n < 2; ++n)
#pragma unroll
                        for (int k = 0; k < 2; ++k) acc[n][4 * hm + mb] = __builtin_amdgcn_mfma_f32_16x16x32_f16(bf[n][k], af[mb][k], acc[n][4 * hm + mb], 0, 0, 0);
                __builtin_amdgcn_sched_barrier(0);
            }
            }
            buf = buf == 2 ? 0 : buf + 1;
        }
        __builtin_amdgcn_s_barrier(); asm volatile("" ::: "memory");
        if (wave < 6) {
        f32x4 s1a[8], s0a[8];
#pragma unroll
        for (int mb = 0; mb < 8; ++mb) { const int db = (128 * rt + 16 * mb + fr) >> 3; const int tt = t < 2 ? 1 : 0;
            s1a[mb] = *(const f32x4*)(st + ((size_t)db * 2 + tt) * FF + c0); s0a[mb] = *(const f32x4*)(st + ((size_t)db * 2) * FF + c0); }
#pragma unroll
        for (int mb = 0; mb < 8; ++mb) {
            const int rl = 128 * rt + 16 * mb + fr, db = rl >> 3; const size_t row = (size_t)MP + rl;
            const f32x4 g = acc[0][mb] * rs[mb], v = acc[1][mb] * rs[mb];
            const f32x4 s1 = s1a[mb], s0 = s0a[mb];
            float h[4];
#pragma unroll
            for (int j = 0; j < 4; ++j) {
                const float p1 = dppz<SHR1>(g[j]), p2 = dppz<SHR2>(g[j]);
                const float gm1 = t >= 1 ? p1 : s1[j], gm2 = t >= 2 ? p2 : (t == 1 ? s1[j] : s0[j]);
                const float gc = b0[j] + w0[j] * gm2 + w1[j] * gm1 + w2[j] * g[j];
                h[j] = gelu_t(gc) * v[j];
            }
            u32x2 o; o.x = pk2h(h[0], h[1]); o.y = pk2h(h[2], h[3]);
            *(u32x2*)(H + row * FF + c0) = o;
            if (t >= 6) *(f32x4*)(fs + ((size_t)db * 2 + (t - 6)) * FF + c0) = g;
        }
        }
    }
#undef SUP_STAGE
}

#define XB_TMO      128
#define XB_XCNT(j)  (256  + 64 * (j))
#define XB_XSUB(j)  (1280 + 64 * (j))
#define XB_XGEN(j)  (2304 + 64 * (j))
#define XB_TOP      3328
#define XB_TOPGEN   3392
#define XCD_BAR_WORDS 3456
#define XB_SPIN_CAP (1u << 18)
__device__ __forceinline__ unsigned xb_ld(unsigned* p)              { return __hip_atomic_load(p, __ATOMIC_RELAXED, __HIP_MEMORY_SCOPE_AGENT); }
__device__ __forceinline__ unsigned xb_add(unsigned* p, unsigned v) { return __hip_atomic_fetch_add(p, v, __ATOMIC_RELAXED, __HIP_MEMORY_SCOPE_AGENT); }
__device__ __forceinline__ unsigned xb_xcc_id() { return (unsigned)__builtin_amdgcn_s_getreg((3 << 11) | 20) & 0xFu; }
#define XB_SPIN(cond, bar) do { unsigned _sp = 0; while (cond) { __builtin_amdgcn_s_sleep(1); \
    if ((++_sp & 255u) == 0u) { if (xb_ld(&(bar)[XB_TMO])) break; if (_sp > XB_SPIN_CAP) { atomicAdd(&(bar)[XB_TMO], 1u); break; } } } } while (0)
struct XcdBarrier { unsigned* bar; unsigned x; volatile LAS unsigned* st; };
__device__ __forceinline__ XcdBarrier xcd_barrier_post(unsigned* bar, volatile LAS unsigned* st) {
    XcdBarrier b; b.bar = bar; b.x = xb_xcc_id(); b.st = st;
    if (threadIdx.x == 0) (void)xb_add(&bar[XB_XCNT(b.x)], 1u);
    return b;
}
__device__ __forceinline__ void xcd_barrier_complete(unsigned* bar, unsigned x, unsigned& nloc, unsigned& nx) {
    const unsigned G = gridDim.x * gridDim.y * gridDim.z;
    unsigned sum, cnt, mine, sp = 0u;
    for (;;) {
        sum = 0u; cnt = 0u; mine = 0u;
#pragma unroll
        for (unsigned j = 0; j < 16; ++j) { const unsigned c = xb_ld(&bar[XB_XCNT(j)]); sum += c; cnt += (c > 0u) ? 1u : 0u; mine = (j == x) ? c : mine; }
        if (sum == G) break;
        __builtin_amdgcn_s_sleep(1);
        if ((++sp & 255u) == 0u) { if (xb_ld(&bar[XB_TMO])) break; if (sp > XB_SPIN_CAP) { atomicAdd(&bar[XB_TMO], 1u); break; } }
    }
    nloc = mine > 0u ? mine : 1u; nx = cnt > 0u ? cnt : 1u;
}
__device__ __forceinline__ void xcd_barrier(const XcdBarrier& b) {
    asm volatile("s_waitcnt vmcnt(0)" ::: "memory");
    __syncthreads();
    if (threadIdx.x == 0) {
        unsigned* bar = b.bar;
        __builtin_amdgcn_s_waitcnt(0);
        unsigned nloc = b.st[0], nx = b.st[1];
        if (nloc == 0u) { xcd_barrier_complete(bar, b.x, nloc, nx); b.st[0] = nloc; b.st[1] = nx; }
        const unsigned old = xb_add(&bar[XB_XSUB(b.x)], 1u);
        const unsigned gen = old / nloc;
        if (old + 1u == (gen + 1u) * nloc) {
            __builtin_amdgcn_fence(__ATOMIC_RELEASE, "agent");
            asm volatile("s_waitcnt vmcnt(0)" ::: "memory");
            const unsigned og = xb_add(&bar[XB_TOP], 1u);
            const unsigned tg = og / nx;
            if (og + 1u == (tg + 1u) * nx) xb_add(&bar[XB_TOPGEN], 1u);
            else XB_SPIN(xb_ld(&bar[XB_TOPGEN]) == tg, bar);
            __builtin_amdgcn_fence(__ATOMIC_ACQUIRE, "agent");
            asm volatile("s_waitcnt vmcnt(0)" ::: "memory");
        } else {
            XB_SPIN(xb_ld(&bar[XB_TOPGEN]) == gen, bar);
            __builtin_amdgcn_fence(__ATOMIC_ACQUIRE, "agent");
            asm volatile("s_waitcnt vmcnt(0)" ::: "memory");
        }
    }
    __syncthreads();
}

struct Args { const float* in[34]; float* out; unsigned char* ws; int ph_lo, ph_hi; unsigned char tab[64]; };
typedef const __attribute__((address_space(4))) Args* ArgsP;
#define IN(k) ((const float*)(const GAS float*)(Ap->in[k]))

__device__ __forceinline__ float wave_sum(float v) {
    v = sum8(v); v += dppf<0x140>(v);
    return sum16_32(v);
}
__device__ __forceinline__ void tr_item(const float* W, int ldw, int c0, const float* gain, f16* Wt, int K, int n0, int k0, LAS float* scr, int lane) {
    f32x4 ld[8];
#pragma unroll
    for (int i = 0; i < 8; ++i) ld[i] = *(const f32x4*)(W + (size_t)(k0 + 8 * i + (lane >> 3)) * ldw + c0 + 4 * (lane & 7));
#pragma unroll
    for (int i = 0; i < 8; ++i) { const int kk = 8 * i + (lane >> 3); f32x4 w = ld[i]; if (gain) w = w * gain[k0 + kk];
        LAS float* d = scr + kk * 33 + 4 * (lane & 7); d[0] = w[0]; d[1] = w[1]; d[2] = w[2]; d[3] = w[3]; }
    asm volatile("s_waitcnt lgkmcnt(0)" ::: "memory");
    const int c = lane & 7;
#pragma unroll
    for (int j = 0; j < 4; ++j) { const int n = (lane >> 3) + 8 * j; const LAS float* s = scr + (8 * c) * 33 + n;
        u32x4 o; o.x = pk2h(s[0 * 33], s[1 * 33]); o.y = pk2h(s[2 * 33], s[3 * 33]); o.z = pk2h(s[4 * 33], s[5 * 33]); o.w = pk2h(s[6 * 33], s[7 * 33]);
        st16_wt(Wt + (size_t)(n0 + n) * K + k0 + 8 * c, o); }
    asm volatile("s_waitcnt lgkmcnt(0)" ::: "memory");
}
__device__ const unsigned char REL_BUCKET[128] = {0,1,2,3,4,5,6,7,8,9,10,11,12,13,14,15,16,16,16,17,17,18,18,18,19,19,19,20,20,20,20,21,21,21,21,22,22,22,22,22,23,23,23,23,23,23,24,24,24,24,24,24,25,25,25,25,25,25,25,26,26,26,26,26,26,26,26,27,27,27,27,27,27,27,27,27,27,28,28,28,28,28,28,28,28,28,28,29,29,29,29,29,29,29,29,29,29,29,29,30,30,30,30,30,30,30,30,30,30,30,30,30,30,31,31,31,31,31,31,31,31,31,31,31,31,31,31,31};

constexpr int KVC_ITEMS = 2 * NDB * 128 * 32, KVC_SPLIT = KVC_ITEMS / 8 * 5;
__device__ __forceinline__ void kvcache_items(ArgsP Ap, unsigned char* ws, float* out, int lo, int hi, int gt, int NT) {
    for (int id0 = lo + gt; id0 < hi; id0 += 4 * NT) {
        f32x4 a[4], b[4];
#pragma unroll
        for (int k = 0; k < 4; ++k) { const int id = id0 + k * NT; if (id < hi) { const int isv = id >= NDB * 128 * 32; const int r = isv ? id - NDB * 128 * 32 : id;
            const float* src = IN(isv ? 6 : 5) + (size_t)r * 8; a[k] = *(const f32x4*)src; b[k] = *(const f32x4*)(src + 4); } }
#pragma unroll
        for (int k = 0; k < 4; ++k) { const int id = id0 + k * NT; if (id < hi) { const int isv = id >= NDB * 128 * 32; const int r = isv ? id - NDB * 128 * 32 : id;
            const int c8 = r & 31, key = (r >> 5) & 127, db = r >> 12;
            u32x4 h; h.x = pk2h(a[k].x, a[k].y); h.y = pk2h(a[k].z, a[k].w); h.z = pk2h(b[k].x, b[k].y); h.w = pk2h(b[k].z, b[k].w);
            st16_wt((f16*)(ws + (isv ? WS_VS16 : WS_KS16)) + ((size_t)db * 160 + key) * 256 + c8 * 8, h);
            if (key >= 8) { float* o = out + (isv ? O_VS : O_KS) + ((size_t)db * 128 + key - 8) * 256 + c8 * 8; st16_wt(o, __builtin_bit_cast(u32x4, a[k])); st16_wt(o + 4, __builtin_bit_cast(u32x4, b[k])); } } }
    }
}
__device__ __forceinline__ void kvcache_zero(unsigned char* ws, int gt, int NT) {
    for (int id = gt; id < 2 * NDB * 24 * 32; id += NT) {
        const int isv = id >= NDB * 24 * 32; const int r = isv ? id - NDB * 24 * 32 : id; const int c8 = r & 31, key = 136 + (r >> 5) % 24, db = (r >> 5) / 24;
        unsigned z0 = 0u; asm volatile("" : "+v"(z0));
        *(u32x4*)((f16*)(ws + (isv ? WS_VS16 : WS_KS16)) + ((size_t)db * 160 + key) * 256 + c8 * 8) = (u32x4){z0, z0, z0, z0};
    }
}

__device__ __forceinline__ void phase_prep(ArgsP Ap, unsigned char* ws, float* out, LAS unsigned char* lds, int vcu, int G, int tid, int lane, int wave) {
    LAS float* scr = (LAS float*)(lds + wave * 16384);
    const int gw = vcu * 8 + wave, NGW = G * 8;
    constexpr int I_IN = 16 * 64, I_G = 4 * 64, I_OUT = 16 * 32, I_UP = 16 * 192, I_DN = 48 * 32, I_Q = 16 * 32, I_O = 16 * 32, I_KV = 16 * 16;
    constexpr int NITEMS = 2 * I_IN + 2 * I_G + 2 * I_OUT + 4 * I_UP + 4 * I_DN + 2 * I_Q + 2 * I_O + I_KV;
    for (int it = gw; it < NITEMS; it += NGW) {
        int r = it;
        if (r < 2 * I_IN) { const int l = r / I_IN; r %= I_IN; const int kb = r / 64, nb = r % 64;
            tr_item(IN(8) + (size_t)l * 1024 * 2048, 2048, 32 * nb, IN(7) + l * 1024, (f16*)(ws + WS_WIN + l * 4 * MiB), 1024, 32 * nb, 64 * kb, scr, lane); continue; } r -= 2 * I_IN;
        if (r < 2 * I_G) { const int l = r / I_G; r %= I_G; const int kb = r / 64, nb = r % 64;
            const int pn = nb >> 3, bj = (nb >> 2) & 1, blk = pn >> 1, dcol = 128 * (pn & 1) + 32 * (nb & 3);
            const float* W = (bj ? IN(13) : IN(11)) + ((size_t)l * 4 + blk) * 65536;
            tr_item(W, 256, dcol, nullptr, (f16*)(ws + WS_WG + l * 1 * MiB), 256, 32 * nb, 64 * kb, scr, lane); continue; } r -= 2 * I_G;
        if (r < 2 * I_OUT) { const int l = r / I_OUT; r %= I_OUT; const int kb = r / 32, nb = r % 32;
            tr_item(IN(16) + (size_t)l * 1024 * 1024, 1024, 32 * nb, nullptr, (f16*)(ws + WS_WOUT + l * 2 * MiB), 1024, 32 * nb, 64 * kb, scr, lane); continue; } r -= 2 * I_OUT;
        if (r < 4 * I_UP) { const int l = r / I_UP; r %= I_UP; const int kb = r / 192, nb = r % 192;
            const int pn = nb >> 3, bj = (nb >> 2) & 1, c0 = (bj ? FF : 0) + 128 * pn + 32 * (nb & 3);
            tr_item(IN(30) + (size_t)l * 1024 * 6144, 6144, c0, IN(29) + l * 1024, (f16*)(ws + WS_WUP + l * 12 * MiB), 1024, 32 * nb, 64 * kb, scr, lane); continue; } r -= 4 * I_UP;
        if (r < 4 * I_DN) { const int l = r / I_DN; r %= I_DN; const int kb = r / 32, nb = r % 32;
            tr_item(IN(33) + (size_t)l * 3072 * 1024, 1024, 32 * nb, nullptr, (f16*)(ws + WS_WDN + l * 6 * MiB), 3072, 32 * nb, 64 * kb, scr, lane); continue; } r -= 4 * I_DN;
        if (r < 2 * I_Q) { const int l = r / I_Q; r %= I_Q; const int kb = r / 32, nb = r % 32;
            const int c0 = 32 * (8 * (nb >> 3) + 2 * (nb & 3) + ((nb >> 2) & 1));
            tr_item(IN(22) + (size_t)l * 1024 * 1024, 1024, c0, IN(21) + l * 1024, (f16*)(ws + WS_WQ + l * 2 * MiB), 1024, 32 * nb, 64 * kb, scr, lane); continue; } r -= 2 * I_Q;
        if (r < 2 * I_O) { const int l = r / I_O; r %= I_O; const int kb = r / 32, nb = r % 32;
            tr_item(IN(26) + (size_t)l * 1024 * 1024, 1024, 32 * nb, nullptr, (f16*)(ws + WS_WO + l * 2 * MiB), 1024, 32 * nb, 64 * kb, scr, lane); continue; } r -= 2 * I_O;
        { const int kb = r / 16, nb = r % 16; const int c0 = 32 * (8 * (nb >> 3) + 2 * (nb & 3) + ((nb >> 2) & 1));
            tr_item(IN(18), 512, c0, IN(17), (f16*)(ws + WS_WKV), 1024, 32 * nb, 64 * kb, scr, lane); }
    }
    f16* X16 = (f16*)(ws + WS_X16); float* SS = (float*)(ws + WS_SS);
    for (int m = gw; m < M; m += NGW) {
        const float* xrow = m < MP ? IN(0) + (size_t)m * 1024 : IN(1) + (size_t)(m - MP) * 1024;
        const f32x4* xr = (const f32x4*)xrow + 2 * lane; float s = 0.f;
        f16* o16 = X16 + (size_t)m * 1024 + 8 * lane;
        f32x4 va[2], vb[2];
#pragma unroll
        for (int j = 0; j < 2; ++j) { va[j] = xr[128 * j]; vb[j] = xr[128 * j + 1]; }
#pragma unroll
        for (int j = 0; j < 2; ++j) { const f32x4 v = va[j], w = vb[j]; s += ((v.x * v.x + v.y * v.y) + (v.z * v.z + v.w * v.w)) + ((w.x * w.x + w.y * w.y) + (w.z * w.z + w.w * w.w));
            u32x4 h; h.x = pk2h(v.x, v.y); h.y = pk2h(v.z, v.w); h.z = pk2h(w.x, w.y); h.w = pk2h(w.z, w.w); st16_wt(o16 + 512 * j, h); }
        s = wave_sum(s);
        if (lane < 16) SS[(size_t)m * 16 + lane] = lane == 0 ? s : 0.f;
    }
    const int gt = vcu * 512 + tid, NT = G * 512;
    kvcache_items(Ap, ws, out, KVC_SPLIT, KVC_ITEMS, gt, NT); kvcache_zero(ws, gt, NT);
    float* CST = (float*)(ws + WS_CONST);
    for (int id = gt; id < 2048; id += NT) { const float lam = IN(15)[id]; const float e = __builtin_amdgcn_exp2f(-lam * LOG2E);
        const float ser = e * (1.0f + e * (-0.5f + e * (0.33333334f + e * (-0.25f + e * 0.2f))));
        const float sp = e < 0.05f ? ser : __builtin_amdgcn_logf(1.0f + e) * 0.6931471806f;
        CST[C_SP2 + id] = 8.0f * sp * LOG2E; }
    for (int id = gt; id < 2048; id += NT) { const int h = id >> 7, dist = id & 127; CST[C_BIAS2 + id] = IN(28)[REL_BUCKET[dist] * 16 + h] * LOG2E; }
    for (int id = gt; id < 32; id += NT) CST[C_SINK2 + id] = IN(25)[id] * LOG2E;
}


__device__ __forceinline__ void convfix_block(const f16* XF, const f16* XL, f16* XC, const float* cw, const float* cb, int pm, int col0, int first, int nthr) {
    (void)nthr;
    if (first >= 0 && first < 128) {
        const int c0 = col0 + (first & 31) * 8, cidx = 4 * pm + (first >> 5);
        const bool seq0 = (cidx & 63) == 0; const int cp = seq0 ? cidx : cidx - 1;
        f32x4 wb[2], w0[2], w1[2], w2[2], w3[2];
#pragma unroll
        for (int q = 0; q < 2; ++q) { wb[q] = *(const f32x4*)(cb + c0 + 4 * q); w0[q] = *(const f32x4*)(cw + c0 + 4 * q); w1[q] = *(const f32x4*)(cw + 1024 + c0 + 4 * q);
                                      w2[q] = *(const f32x4*)(cw + 2048 + c0 + 4 * q); w3[q] = *(const f32x4*)(cw + 3072 + c0 + 4 * q); }
        f16x8 f[3], l[3];
#pragma unroll
        for (int k = 0; k < 3; ++k) { f[k] = *(const f16x8*)(XF + ((size_t)cidx * 3 + k) * 1024 + c0); l[k] = *(const f16x8*)(XL + ((size_t)cp * 3 + k) * 1024 + c0); }
        float o0[8], o1[8], o2[8];
#pragma unroll
        for (int i = 0; i < 8; ++i) {
            const float b = wb[i >> 2][i & 3], a0 = w0[i >> 2][i & 3], a1 = w1[i >> 2][i & 3], a2 = w2[i >> 2][i & 3], a3 = w3[i >> 2][i & 3];
            const float m1 = seq0 ? 0.f : (float)l[2][i], m2 = seq0 ? 0.f : (float)l[1][i], m3 = seq0 ? 0.f : (float)l[0][i];
            const float x0 = (float)f[0][i], x1 = (float)f[1][i], x2 = (float)f[2][i];
            o0[i] = b + a3 * x0 + a2 * m1 + a1 * m2 + a0 * m3;
            o1[i] = b + a3 * x1 + a2 * x0 + a1 * m1 + a0 * m2;
            o2[i] = b + a3 * x2 + a2 * x1 + a1 * x0 + a0 * m1;
        }
        st8(XC + ((size_t)cidx * 64) * 1024 + c0, o0); st8(XC + ((size_t)cidx * 64 + 1) * 1024 + c0, o1); st8(XC + ((size_t)cidx * 64 + 2) * 1024 + c0, o2);
    }
}

__device__ __forceinline__ void phase_scan2(const f16* HL, const f16* AC, const f16* GG, f16* Y, const float* P, const float* Hl, const float* hst  , float* hp  , float* hs  , int gt, int NT) {
    for (int id = gt; id < 4 * 64 * 512 + NDB * 128; id += NT) {
        float c[8]; size_t row0; int nstep; float* fin = nullptr; int cg;
        if (id < 4 * 64 * 512) {
            cg = id & 127; const int rq = (id >> 7) & 3, bc = id >> 9, ch = bc & 63, b = bc >> 6;
#pragma unroll
            for (int i = 0; i < 8; ++i) c[i] = 0.f;
            const float* Pb = P + (size_t)(b * 64) * 1024 + cg * 8; const float* Hb = Hl + (size_t)(b * 64) * 1024 + cg * 8;
            int j = 0;
            for (; j + 4 <= ch; j += 4) {
                f32x4 p[4][2], q[4][2];
#pragma unroll
                for (int k = 0; k < 4; ++k) { p[k][0] = *(const f32x4*)(Pb + (size_t)(j + k) * 1024); p[k][1] = *(const f32x4*)(Pb + (size_t)(j + k) * 1024 + 4);
                                              q[k][0] = *(const f32x4*)(Hb + (size_t)(j + k) * 1024); q[k][1] = *(const f32x4*)(Hb + (size_t)(j + k) * 1024 + 4); }
#pragma unroll
                for (int k = 0; k < 4; ++k)
#pragma unroll
                    for (int i = 0; i < 8; ++i) c[i] = p[k][i >> 2][i & 3] * c[i] + q[k][i >> 2][i & 3];
            }
            for (; j < ch; ++j) { const f32x4 p0 = *(const f32x4*)(Pb + (size_t)j * 1024), p1 = *(const f32x4*)(Pb + (size_t)j * 1024 + 4), q0 = *(const f32x4*)(Hb + (size_t)j * 1024), q1 = *(const f32x4*)(Hb + (size_t)j * 1024 + 4);
#pragma unroll
                for (int i = 0; i < 4; ++i) { c[i] = p0[i] * c[i] + q0[i]; c[4 + i] = p1[i] * c[4 + i] + q1[i]; } }
            row0 = (size_t)bc * 64 + rq * 16; nstep = 16; if (ch == 63 && rq == 3) fin = hp + b * 1024 + cg * 8;
        } else {
            const int r = id - 4 * 64 * 512; cg = r & 127; const int db = r >> 7;
            const f32x4 q0 = *(const f32x4*)(hst + (size_t)db * 1024 + cg * 8), q1 = *(const f32x4*)(hst + (size_t)db * 1024 + cg * 8 + 4);
#pragma unroll
            for (int i = 0; i < 4; ++i) { c[i] = q0[i]; c[4 + i] = q1[i]; }
            row0 = (size_t)MP + db * 8; nstep = 8; fin = hs + (size_t)db * 1024 + cg * 8;
        }
        const f16* hl = HL + row0 * 1024 + cg * 8; const f16* ac = AC + row0 * 1024 + cg * 8; const f16* gg = GG + row0 * 1024 + cg * 8; f16* y = Y + row0 * 1024 + cg * 8;
        float h[8];
#pragma unroll
        for (int i = 0; i < 8; ++i) h[i] = 0.f;
#pragma unroll 4
        for (int s = 0; s < nstep; ++s) {
            const f16x8 l = *(const f16x8*)(hl + (size_t)s * 1024), a = *(const f16x8*)(ac + (size_t)s * 1024), g = *(const f16x8*)(gg + (size_t)s * 1024);
            float o[8];
#pragma unroll
            for (int i = 0; i < 8; ++i) { h[i] = (float)l[i] + (float)a[i] * c[i]; o[i] = (float)g[i] * h[i]; }
            st8(y + (size_t)s * 1024, o);
        }
        if (fin) { *(f32x4*)fin = (f32x4){h[0], h[1], h[2], h[3]}; *(f32x4*)(fin + 4) = (f32x4){h[4], h[5], h[6], h[7]}; }
    }
}

__device__ __forceinline__ void fix_panel(const f16* GF, const f16* VF, const f16* GL, f16* H, const float* cw, const float* cb, int pm, int first, int nthr) {
    (void)nthr;
    if (first < 384) {
        const int c0 = first * 8;
        f16x2 wb[4], w0[4], w1[4], w2[4];
#pragma unroll
        for (int j = 0; j < 4; ++j) { wb[j] = h2(cb[c0 + 2 * j], cb[c0 + 2 * j + 1]); w0[j] = h2(cw[c0 + 2 * j], cw[c0 + 2 * j + 1]); w1[j] = h2(cw[FF + c0 + 2 * j], cw[FF + c0 + 2 * j + 1]); w2[j] = h2(cw[2 * FF + c0 + 2 * j], cw[2 * FF + c0 + 2 * j + 1]); }
        u32x4 gf0a[4], gf1a[4], vf0a[4], vf1a[4], gl0a[4], gl1a[4];
#pragma unroll
        for (int cc = 0; cc < 4; ++cc) {
            const int cidx = 4 * pm + cc; const bool firstc = (cidx & 63) == 0; const int cp = firstc ? cidx : cidx - 1;
            gf0a[cc] = *(const u32x4*)(GF + ((size_t)cidx * 2) * FF + c0); gf1a[cc] = *(const u32x4*)(GF + ((size_t)cidx * 2 + 1) * FF + c0);
            vf0a[cc] = *(const u32x4*)(VF + ((size_t)cidx * 2) * FF + c0); vf1a[cc] = *(const u32x4*)(VF + ((size_t)cidx * 2 + 1) * FF + c0);
            gl0a[cc] = *(const u32x4*)(GL + ((size_t)cp * 2) * FF + c0); gl1a[cc] = *(const u32x4*)(GL + ((size_t)cp * 2 + 1) * FF + c0);
        }
#pragma unroll
        for (int cc = 0; cc < 4; ++cc) {
            const int cidx = 4 * pm + cc; const bool firstc = (cidx & 63) == 0;
            const u32x4 gf0 = gf0a[cc], gf1 = gf1a[cc], vf0 = vf0a[cc], vf1 = vf1a[cc];
            u32x4 gl0 = gl0a[cc], gl1 = gl1a[cc];
            if (firstc) { gl0 = (u32x4){0u, 0u, 0u, 0u}; gl1 = gl0; }
            f16x2 gc0[4], gc1[4], ge0[4], ge1[4];
#pragma unroll
            for (int j = 0; j < 4; ++j) {
                const unsigned a_ = gf0[j], b_ = gf1[j], c_ = gl0[j], d_ = gl1[j];
                const f16x2 x0 = __builtin_bit_cast(f16x2, a_), x1 = __builtin_bit_cast(f16x2, b_), pm2 = __builtin_bit_cast(f16x2, c_), pm1 = __builtin_bit_cast(f16x2, d_);
                gc0[j] = wb[j] + w0[j] * pm2 + w1[j] * pm1 + w2[j] * x0;
                gc1[j] = wb[j] + w0[j] * pm1 + w1[j] * x0 + w2[j] * x1;
            }
            gelu4_h2(gc0, ge0); gelu4_h2(gc1, ge1);
            u32x4 h0, h1;
#pragma unroll
            for (int j = 0; j < 4; ++j) { const unsigned e_ = vf0[j], f_ = vf1[j]; h0[j] = __builtin_bit_cast(unsigned, ge0[j] * __builtin_bit_cast(f16x2, e_)); h1[j] = __builtin_bit_cast(unsigned, ge1[j] * __builtin_bit_cast(f16x2, f_)); }
            *(u32x4*)(H + ((size_t)cidx * 64) * FF + c0) = h0; *(u32x4*)(H + ((size_t)cidx * 64 + 1) * FF + c0) = h1;
        }
    }
}

__device__ __forceinline__ int crow(int r, int hi) { return (r & 3) + 8 * (r >> 2) + 4 * hi; }
constexpr int ATT_K = 0, ATT_V = 32768, ATT_BIAS = 81920, ATT_STG = 106496;
constexpr int ATT_SK = 20480, ATT_SV = 40960;
__device__ __forceinline__ void attn_group(LAS unsigned char* lds, const f16x8 (&qf)[4], f16* O, int head, int qoff, int sjmin, int tile0, float sink2, int lane, int wave, int omode, int orow0, int ohead0, int koff, int voff) {
    const int q31 = lane & 31, hi = lane >> 5;
    f32x16 s[5];
#pragma unroll
    for (int kt = 0; kt < 5; ++kt) s[kt] = (f32x16){};
#pragma unroll
    for (int ds = 0; ds < 4; ++ds) {
#pragma unroll
        for (int kt = 0; kt < 5; ++kt) {
            const int key = (tile0 + kt) * 32 + q31;
            const f16x8 kf = *(const LAS f16x8*)(lds + koff + key * 128 + (((ds * 2 + hi) ^ (key & 7)) << 4));
            s[kt] = __builtin_amdgcn_mfma_f32_32x32x16_f16(kf, qf[ds], s[kt], 0, 0, 0);
        }
        __builtin_amdgcn_sched_barrier(0);
    }
    float mx = sink2;
    if (sjmin == 0) {
        const LAS float* tb = (const LAS float*)(lds + ATT_BIAS) + head * 384 + 128 + (qoff - 32 * tile0 - 4 * hi);
#pragma unroll
        for (int kt = 0; kt < 5; ++kt)
#pragma unroll
            for (int r = 0; r < 16; ++r) { const float sc = s[kt][r] + tb[-(32 * kt + (r & 3) + 8 * (r >> 2))]; s[kt][r] = sc; mx = fmaxf(mx, sc); }
    } else {
        const LAS float* tb = (const LAS float*)(lds + ATT_BIAS) + head * 384 + 128;
#pragma unroll
        for (int kt = 0; kt < 5; ++kt)
#pragma unroll
            for (int r = 0; r < 16; ++r) {
                const int sj = (tile0 + kt) * 32 + crow(r, hi); const int dist = qoff - sj;
                const float sc = (sj >= sjmin) ? s[kt][r] + tb[dist] : -1e30f;
                s[kt][r] = sc; mx = fmaxf(mx, sc);
            }
    }
    mx = fmaxf(mx, other32f(mx));
    float l = 0.f;
#pragma unroll
    for (int kt = 0; kt < 5; ++kt)
#pragma unroll
        for (int r = 0; r < 16; ++r) { const float p = __builtin_amdgcn_exp2f(s[kt][r] - mx); s[kt][r] = p; l += p; }
    l += other32f(l);
    const float rden = __builtin_amdgcn_rcpf(l + __builtin_amdgcn_exp2f(sink2 - mx));
    f32x16 o4[2][2];
#pragma unroll
    for (int a_ = 0; a_ < 2; ++a_) { o4[a_][0] = (f32x16){}; o4[a_][1] = (f32x16){}; }
#pragma unroll
    for (int kt = 0; kt < 5; ++kt)
#pragma unroll
        for (int s2 = 0; s2 < 2; ++s2) {
            u32x4 pw; pw.x = pk2h(s[kt][8 * s2 + 0], s[kt][8 * s2 + 1]); pw.y = pk2h(s[kt][8 * s2 + 2], s[kt][8 * s2 + 3]); pw.z = pk2h(s[kt][8 * s2 + 4], s[kt][8 * s2 + 5]); pw.w = pk2h(s[kt][8 * s2 + 6], s[kt][8 * s2 + 7]);
            const f16x8 pb = __builtin_bit_cast(f16x8, pw);
            const int ka = (tile0 + kt) * 32 + 16 * s2 + 4 * hi + ((lane & 15) >> 2), kb = ka + 8;
#pragma unroll
            for (int db = 0; db < 2; ++db) {
                const int col = 32 * db + 16 * ((lane >> 4) & 1) + 4 * (lane & 3);
                const s16x4 lo = __builtin_amdgcn_ds_read_tr16_b64_v4i16((LAS s16x4*)(lds + voff + ka * 128 + ((((col >> 3) ^ (ka & 7)) << 4) | ((col & 7) * 2))));
                const s16x4 hh = __builtin_amdgcn_ds_read_tr16_b64_v4i16((LAS s16x4*)(lds + voff + kb * 128 + ((((col >> 3) ^ (kb & 7)) << 4) | ((col & 7) * 2))));
                typedef short s16x8 __attribute__((ext_vector_type(8)));
                const s16x8 vv = {lo[0], lo[1], lo[2], lo[3], hh[0], hh[1], hh[2], hh[3]};
                o4[db][s2] = __builtin_amdgcn_mfma_f32_32x32x16_f16(__builtin_bit_cast(f16x8, vv), pb, o4[db][s2], 0, 0, 0);
            }
        }
    f32x16 o[2]; o[0] = o4[0][0] + o4[0][1]; o[1] = o4[1][0] + o4[1][1];
    LAS unsigned char* stg = lds + ATT_STG + wave * 4608;
#pragma unroll
    for (int db = 0; db < 2; ++db)
#pragma unroll
        for (int c = 0; c < 4; ++c) {
            u32x2 h; h.x = pk2h(o[db][4 * c] * rden, o[db][4 * c + 1] * rden); h.y = pk2h(o[db][4 * c + 2] * rden, o[db][4 * c + 3] * rden);
            *(LAS u32x2*)(stg + q31 * 144 + (32 * db + 8 * c + 4 * hi) * 2) = h;
        }
#pragma unroll
    for (int i = 0; i < 4; ++i) {
        const int r = 8 * i + (lane >> 3), ch = lane & 7;
        const u32x4 v = *(const LAS u32x4*)(stg + r * 144 + ch * 16);
        const int grow = omode ? orow0 + (r & 7) : orow0 + r, ghead = omode ? ohead0 + (r >> 3) : ohead0;
        st16_wt(O + (size_t)grow * 1024 + ghead * 64 + ch * 8, v);
    }
}
__device__ __forceinline__ void phase_attn(LAS unsigned char* lds, const f16* Q, f16* O, const f16* K16, const f16* V16, const f16* KS16, const f16* VS16, const float* bias2, const float* sink2,
                                           int vcu, int G, int tid, int lane, int wave) {
    LAS float* bt = (LAS float*)(lds + ATT_BIAS);
    {   float bv[4];
#pragma unroll
        for (int k = 0; k < 4; ++k) bv[k] = bias2[tid + 512 * k];
#pragma unroll
        for (int k = 0; k < 8; ++k) { const int i = tid + 512 * k, h = i >> 8, r = i & 255; bt[h * 384 + (r < 128 ? r : r + 128)] = -1e30f; }
#pragma unroll
        for (int k = 0; k < 4; ++k) { const int i = tid + 512 * k; bt[(i >> 7) * 384 + 128 + (i & 127)] = bv[k]; }
    }
    for (int unit = vcu; unit < 768; unit += G) {
        __syncthreads();
        const bool samp = unit >= 512;
        int b = 0, kvh = 0, j = 0, db = 0;
        f16x8 qa[4];
        if (!samp) {
            b = unit >> 7; kvh = (unit >> 5) & 3; j = unit & 31;
            {   const f16* qp = Q + (size_t)(b * 4096 + j * 128 + 64 * (wave & 1) + (lane & 31)) * 1024 + (kvh * 4 + (wave >> 1)) * 64 + (lane >> 5) * 8;
#pragma unroll
                for (int ds = 0; ds < 4; ++ds) qa[ds] = *(const f16x8*)(qp + ds * 16); }
#pragma unroll
            for (int i = 0; i < 4; ++i) {
                const int c = tid + 512 * i, key = c >> 3, ch = c & 7;
                u32x4 kv = {0u, 0u, 0u, 0u}, vv = {0u, 0u, 0u, 0u};
                if (j > 0 || key >= 128) { const size_t row = (size_t)(b * 4096 + (j - 1) * 128 + key); kv = *(const u32x4*)(K16 + row * 256 + kvh * 64 + ch * 8); vv = *(const u32x4*)(V16 + row * 256 + kvh * 64 + ch * 8); }
                const int off = key * 128 + ((ch ^ (key & 7)) << 4);
                *(LAS u32x4*)(lds + ATT_K + off) = kv; *(LAS u32x4*)(lds + ATT_V + off) = vv;
            }
        } else {
            const int p = unit - 512; db = p >> 1; kvh = 2 * (p & 1);
            if (wave < 2) { const int q = lane & 31; const f16* qp = Q + (size_t)(MP + db * 8 + (q & 7)) * 1024 + ((kvh + wave) * 4 + (q >> 3)) * 64 + (lane >> 5) * 8;
#pragma unroll
                for (int ds = 0; ds < 4; ++ds) qa[ds] = *(const f16x8*)(qp + ds * 16); }
#pragma unroll
            for (int i = 0; i < 5; ++i) {
                const int c = tid + 512 * i, key = c >> 4, c16 = c & 15, ub = c16 >> 3, ch = c16 & 7;
                const size_t g = ((size_t)db * 160 + key) * 256 + kvh * 64 + c16 * 8;
                const u32x4 kv = *(const u32x4*)(KS16 + g), vv = *(const u32x4*)(VS16 + g);
                const int off = ub * ATT_SK + key * 128 + ((ch ^ (key & 7)) << 4);
                *(LAS u32x4*)(lds + off) = kv; *(LAS u32x4*)(lds + ATT_SV + off) = vv;
            }
        }
        __syncthreads();
        if (!samp) {
            const int g = wave >> 1, half = wave & 1, head = kvh * 4 + g;
            const float sk = sink2[head];
#pragma unroll 1
            for (int grp = 0; grp < 2; ++grp) {
                const int qi = 64 * half + 32 * grp + (lane & 31);
                f16x8 qf[4];
                if (grp) { const f16* qp = Q + (size_t)(b * 4096 + j * 128 + qi) * 1024 + head * 64 + (lane >> 5) * 8;
#pragma unroll
                    for (int ds = 0; ds < 4; ++ds) qf[ds] = *(const f16x8*)(qp + ds * 16);
                } else {
#pragma unroll
                    for (int ds = 0; ds < 4; ++ds) qf[ds] = qa[ds];
                }
                attn_group(lds, qf, O, head, qi + 128, j == 0 ? 128 : 0, 2 * half + grp, sk, lane, wave, 0, b * 4096 + j * 128 + 64 * half + 32 * grp, head, ATT_K, ATT_V);
            }
        } else if (wave < 2) {
            const int q = lane & 31, g = q >> 3, t = q & 7, head = (kvh + wave) * 4 + g;
            attn_group(lds, qa, O, head, t + 128, 0, 0, sink2[head], lane, wave, 1, MP + db * 8, (kvh + wave) * 4, wave * ATT_SK, ATT_SV + wave * ATT_SK);
        }
    }
    __syncthreads();
}

enum PhaseKind { PK_PREP, PK_IN, PK_GATE, PK_SCAN2, PK_OUT, PK_UP, PK_DOWN, PK_KV, PK_Q, PK_ATTN, PK_WO };
constexpr int NPHASE = 21;
__host__ __device__ __forceinline__ int base_kind(int b) {
    if (b == 0) return PK_PREP;
    if (b <= 10) { const int p = (b - 1) % 5; return p == 0 ? PK_IN : p == 1 ? PK_GATE : p == 2 ? PK_OUT : p == 3 ? PK_UP : PK_DOWN; }
    if (b == 11) return PK_KV;
    const int p = b <= 15 ? b - 11 : b - 16; return p == 0 ? PK_Q : p == 1 ? PK_ATTN : p == 2 ? PK_WO : p == 3 ? PK_UP : PK_DOWN; }
__device__ __forceinline__ void phase_decode(int ph, int& kind, int& layer) {
    kind = base_kind(ph);
    layer = ph == 0 ? 0 : ph <= 10 ? (ph - 1) / 5 : ph == 11 ? 1 : ph <= 15 ? 2 : 3;
}
__host__ __device__ __forceinline__ int nphase_total() { int n = 0; for (int b = 0; b < NPHASE; ++b) n += (base_kind(b) == PROBE_KIND) ? PROBE_REP : 1; return n; }
__device__ __forceinline__ void phase_decode_x(int ph, int& kind, int& layer, bool& dry, bool& probe_extra) {
#if PROBE_KIND >= 0
    const int code = ((const __attribute__((address_space(4))) unsigned char*)__builtin_amdgcn_kernarg_segment_ptr())[__builtin_offsetof(Args, tab) + ph];
    const int b = code & 63;
    probe_extra = (code >> 6) != 0;
#if PROBE_KIND == 4 || PROBE_KIND == 6 || PROBE_KIND == 10
    dry = probe_extra;
#else
    dry = false;
#endif
    phase_decode(b, kind, layer);
#else
    dry = false; probe_extra = false; phase_decode(ph, kind, layer);
#endif
}
__global__ void __launch_bounds__(512, 2) yoco_fwd(Args A) {
    extern __shared__ __attribute__((aligned(16))) unsigned char lds_raw[];
    LAS unsigned char* lds = (LAS unsigned char*)lds_raw;
    const int tid0 = threadIdx.x;
    const int wave0 = __builtin_amdgcn_readfirstlane(tid0 >> 6);
    const int G = gridDim.x; const int bx = blockIdx.x; const int vcu = (G % 8 == 0) ? (bx % 8) * (G / 8) + bx / 8 : bx;
    volatile LAS unsigned* MISC = (volatile LAS unsigned*)(lds + MISC_OFF);
    for (int u = tid0; u < (LDS_BYTES - LDSCTL_OFF) / 4; u += 512) ((LAS unsigned*)(lds + LDSCTL_OFF))[u] = 0u;
    __syncthreads();
    XcdBarrier bar; bar.bar = (unsigned*)(A.ws + WS_CTL) + CW_BAR; bar.x = 0; bar.st = nullptr;
    const bool multi = (A.ph_hi - A.ph_lo) > 1;
    if (multi) bar = xcd_barrier_post((unsigned*)(A.ws + WS_CTL) + CW_BAR, MISC + 8);

    for (int ph = A.ph_lo; ph < A.ph_hi; ++ph) {
#define FRESH_TID(name) int name; { int z_ = 0; asm volatile("" : "+v"(z_)); name = wave0 * 64 + (int)__builtin_amdgcn_mbcnt_hi(~0u, __builtin_amdgcn_mbcnt_lo(~0u, (unsigned)z_)); }
#define FRESH_ARGS ArgsP Ap = (ArgsP)__builtin_amdgcn_kernarg_segment_ptr(); asm volatile("" : "+s"(Ap)); \
        unsigned char* ws = (unsigned char*)(GAS unsigned char*)Ap->ws; float* out = (float*)(GAS float*)Ap->out; (void)out; \
        float* CST = (float*)(ws + WS_CONST); float* SS = (float*)(ws + WS_SS); f16* X16 = (f16*)(ws + WS_X16); (void)CST; (void)SS; (void)X16;
        const int NT = G * 512; const int wave = wave0;
        const bool small_first = (bx >> 3) & 1;
        int kind, L; bool dry, probe_extra; phase_decode_x(ph, kind, L, dry, probe_extra); (void)probe_extra;
        pg8::StaticOrder S;
        switch (kind) {
        case PK_PREP: { FRESH_ARGS; FRESH_TID(tid); phase_prep(Ap, ws, out, lds, vcu, G, tid, tid & 63, wave); } break;
        case PK_IN: { FRESH_ARGS; FRESH_TID(tid);
            pg8::Gemm g{X16, (const f16*)(ws + WS_WIN + L * 4 * MiB), MP, 2048, 1024, 1024, 0}; S.init(MP, 2048, G, bx);
            EpiIn E{SS, (f16*)(ws + WS_GG), (f16*)(ws + WS_XC), (f16*)(ws + WS_XF), (f16*)(ws + WS_XL), IN(9) + L * 4 * 1024, IN(10) + L * 1024, out + O_CP + (size_t)L * 4 * 3 * 1024};
            sg::SGemm sgm{X16, 1024, g.Bt, 1024}; SEpiIn SE{SS, E.GG, E.XC, E.cw, E.cb, IN(3) + (size_t)L * NDB * 3 * 1024, out + O_CS + (size_t)L * NDB * 3 * 1024};
#pragma unroll 1
            for (int pass = 0; pass < 2; ++pass) {
                if ((pass == 0) != small_first) { FRESH_TID(tidb); pg8::gemm_phase<EpiIn>(lds, g, S, E, tidb); }
                else if (!PROBE_SKIP_SMALL) { FRESH_TID(tid2); sg::sgemm_staged<SEpiIn>(lds, sgm, 32, SE, vcu, G, tid2); }
            } } break;
        case PK_GATE: { FRESH_ARGS;
            pg8::Gemm g{(const f16*)(ws + WS_XC), (const f16*)(ws + WS_WG + L * MiB), MP, 2048, 256, 1024, 1}; S.init(MP, 2048, G, bx, true);
            EpiGate E{(const f16*)(ws + WS_XC), (const f16*)(ws + WS_GG), (f16*)(ws + WS_Y16), (float*)(ws + WS_PH + L * MiB), (unsigned*)(ws + WS_CTL) + CW_GFLAG + L * 512, out + O_HP + (size_t)L * 4 * 1024,
                      IN(12) + L * 1024, IN(14) + L * 1024, CST + C_SP2 + L * 1024, lds};
            {
                FRESH_TID(tp);
                pg8::Unit uu; for (int i = 0; S.next(i, uu); ++i) convfix_block((const f16*)(ws + WS_XF), (const f16*)(ws + WS_XL), (f16*)(ws + WS_XC), IN(9) + L * 4 * 1024, IN(10) + L * 1024, uu.pm, (uu.pn >> 1) * 256, tp - 128 * (i & 3), 512);
                asm volatile("s_waitcnt vmcnt(0)" ::: "memory"); __syncthreads();
            }
            FRESH_TID(tid);
            pg8::gemm_phase<EpiGate>(lds, g, S, E, tid);
            sg::SGemm sgm{g.A, 1024, g.Bt, 256}; SEpiGate SE{nullptr, E.XC, E.GG, E.Y, IN(2) + (size_t)L * NDB * 1024, out + O_HS + (size_t)L * NDB * 1024, E.br, E.bi, E.sp2};
            if (!PROBE_SKIP_SMALL) { FRESH_TID(tid2); sg::sgemm_staged<SEpiGate>(lds, sgm, 32, SE, vcu, G, tid2); } } break;
        case PK_OUT: case PK_WO: case PK_DOWN: { FRESH_ARGS;
            pg8::Gemm g; const float* bias = nullptr; const float* xp = nullptr; const float* xs = nullptr; float* yp = nullptr; float* ys = nullptr;
            if (kind == PK_OUT) { g = pg8::Gemm{(const f16*)(ws + WS_Y16), (const f16*)(ws + WS_WOUT + L * 2 * MiB), MP, 1024, 1024, 1024, 0}; }
            else if (kind == PK_WO) { g = pg8::Gemm{(const f16*)(ws + WS_O16), (const f16*)(ws + WS_WO + (L - 2) * 2 * MiB), MP, 1024, 1024, 1024, 0}; bias = IN(27) + (L - 2) * 1024; }
            else { g = pg8::Gemm{(const f16*)(ws + WS_H16), (const f16*)(ws + WS_WDN + L * 6 * MiB), MP, 1024, 3072, 3072, 0}; if (L == 3) { yp = out; ys = out + (size_t)MP * 1024; } }
            S.init(MP, 1024, G, bx);
            if (kind == PK_DOWN) {
                FRESH_TID(tp);
                pg8::Unit uu; for (int i = 0; S.next(i, uu); ++i) fix_panel((const f16*)(ws + WS_GF), (const f16*)(ws + WS_VF), (const f16*)(ws + WS_GL), (f16*)(ws + WS_H16), IN(31) + (size_t)L * 3 * FF, IN(32) + (size_t)L * FF, uu.pm, tp, 512);
                asm volatile("s_waitcnt vmcnt(0)" ::: "memory"); __syncthreads();
            }
            EpiRes E{xp, yp, X16, SS, bias, dry};
            sg::SGemm sgm{g.A, g.lda, g.Bt, g.K}; SEpiRes SE{xs, ys, X16, SS, bias, dry};
#pragma unroll 1
            for (int pass = 0; pass < 2; ++pass) {
                if ((pass == 0) != small_first) { FRESH_TID(tidb); pg8::gemm_phase<EpiRes>(lds, g, S, E, tidb); }
                else if (!PROBE_SKIP_SMALL) { FRESH_TID(tid2); sg::sgemm_staged<SEpiRes>(lds, sgm, 16, SE, vcu, G, tid2); }
            } } break;
        case PK_UP: { FRESH_ARGS; FRESH_TID(tid);
            pg8::Gemm g{X16, (const f16*)(ws + WS_WUP + L * 12 * MiB), MP, 6144, 1024, 1024, 0}; S.init(MP, 6144, G, bx);
            EpiUp E{SS, (f16*)(ws + WS_H16), (f16*)(ws + WS_GF), (f16*)(ws + WS_VF), (f16*)(ws + WS_GL), IN(31) + (size_t)L * 3 * FF, IN(32) + (size_t)L * FF,
                    IN(4) + (size_t)L * NDB * 2 * FF, out + O_FP + (size_t)L * 4 * 2 * FF, out + O_FS + (size_t)L * NDB * 2 * FF, lds, false};
#if PROBE_KIND == 5 && defined(PROBE_NULLEPI)
            if (probe_extra) { EpiNull EN{(float*)(ws + WS_GF)}; pg8::gemm_phase<EpiNull>(lds, g, S, EN, tid); break; }
#endif
#pragma unroll 1
            for (int pass = 0; pass < 2; ++pass) {
                if ((pass == 0) != small_first) { FRESH_TID(tidb); E.pre = up_preload(lds, S, SS, E.cw, E.cb, tidb); pg8::gemm_phase<EpiUp>(lds, g, S, E, tidb); }
                else if (!PROBE_SKIP_SMALL) { FRESH_TID(tid2); if (G == 256) sup_phase96(lds, X16, g.Bt, SS, E.H, E.cw, E.cb, E.st, E.fs, vcu, G, tid2); else sup_phase(lds, X16, g.Bt, SS, E.H, E.cw, E.cb, E.st, E.fs, vcu, G, tid2); }
            } } break;
        case PK_KV: { FRESH_ARGS; FRESH_TID(tid);
            pg8::Gemm g{X16, (const f16*)(ws + WS_WKV), MP, 1536, 1024, 1024, 0}; S.init(MP, 1536, G, bx);
            EpiKVQ E{EpiKV{SS, IN(19), IN(20), (f16*)(ws + WS_K16), (f16*)(ws + WS_V16), (f16*)(ws + WS_KS16), (f16*)(ws + WS_VS16), out}, EpiQ{SS, IN(23), IN(24), (f16*)(ws + WS_Q16)}};
            sg::SGemm sgm{X16, 1024, g.Bt, 1024}; SEpiKVQ SE{SEpiKV{SS, E.kv.bkv, E.kv.knorm, E.kv.KS16, E.kv.VS16, out}, SEpiQ{SS, E.q.bq, E.q.qnorm, E.q.Q16}, SS};
            const int hidx = bx - G / 2, hcnt = G - G / 2;
            if (!PROBE_SKIP_SMALL && hidx >= 0) { FRESH_TID(tid2); sg::sgemm_staged<SEpiKVQ>(lds, sgm, 24, SE, hidx, hcnt, tid2); }
            { FRESH_TID(tidb); pg8::gemm_phase<EpiKVQ>(lds, g, S, E, tidb); }
            if (hidx >= 0) { FRESH_TID(tid3); kvcache_items(Ap, ws, out, 0, KVC_SPLIT, hidx * 512 + tid3, hcnt * 512); } } break;
        case PK_Q: { FRESH_ARGS; FRESH_TID(tid);
            pg8::Gemm g{X16, (const f16*)(ws + WS_WQ + (L - 2) * 2 * MiB), MP, 1024, 1024, 1024, 0}; S.init(MP, 1024, G, bx);
            EpiQ E{SS, IN(23) + (L - 2) * 1024, IN(24) + (L - 2) * 64, (f16*)(ws + WS_Q16)};
            sg::SGemm sgm{X16, 1024, g.Bt, 1024}; SEpiQ SE{SS, E.bq, E.qnorm, E.Q16};
#pragma unroll 1
            for (int pass = 0; pass < 2; ++pass) {
                if ((pass == 0) != small_first) { FRESH_TID(tidb); pg8::gemm_phase<EpiQ>(lds, g, S, E, tidb); }
                else if (!PROBE_SKIP_SMALL) { FRESH_TID(tid2); sg::sgemm_staged<SEpiQ>(lds, sgm, 16, SE, vcu, G, tid2); }
            } } break;
        case PK_ATTN: { FRESH_ARGS; FRESH_TID(tid);
            phase_attn(lds, (const f16*)(ws + WS_Q16), (f16*)(ws + WS_O16), (const f16*)(ws + WS_K16), (const f16*)(ws + WS_V16), (const f16*)(ws + WS_KS16), (const f16*)(ws + WS_VS16),
                       CST + C_BIAS2, CST + C_SINK2 + (L - 2) * 16, vcu, G, tid, tid & 63, wave); } break;
        }
        if (ph + 1 < A.ph_hi) xcd_barrier(bar);
    }
}

extern "C" void kernel_launch(void* const* d_in, const int* in_sizes, int n_in, void* d_out, int out_size, void* d_ws, size_t ws_size, hipStream_t stream) {
    static int grid = 0;
    if (grid == 0) {
        if (n_in != 34 || out_size != (int)O_END || ws_size < WS_END) { fprintf(stderr, "kernel_launch: unexpected shapes: n_in %d out %d ws %zu (need %zu)\n", n_in, out_size, ws_size, (size_t)WS_END); grid = -1; return; }
        int dev = 0, cus = 0;
        if (hipGetDevice(&dev) != hipSuccess || hipDeviceGetAttribute(&cus, hipDeviceAttributeMultiprocessorCount, dev) != hipSuccess) { grid = -1; return; }
        if (hipFuncSetAttribute((const void*)yoco_fwd, hipFuncAttributeMaxDynamicSharedMemorySize, LDS_BYTES) != hipSuccess) { fprintf(stderr, "kernel_launch: hipFuncSetAttribute failed\n"); grid = -1; return; }
        int per_cu = 0;
        if (hipOccupancyMaxActiveBlocksPerMultiprocessor(&per_cu, (const void*)yoco_fwd, 512, LDS_BYTES) != hipSuccess || per_cu < 1) fprintf(stderr, "kernel_launch: occupancy query says %d blocks per CU\n", per_cu);
        (void)hipGetLastError();
        grid = cus;
    }
    if (grid < 0) return;
    (void)hipMemsetAsync((char*)d_ws + WS_CTL, 0, CTL_ZERO_BYTES, stream);
    Args a{};
    for (int i = 0; i < 34; ++i) a.in[i] = (const float*)d_in[i];
    a.out = (float*)d_out; a.ws = (unsigned char*)d_ws;
#if MK_PER_PHASE
    for (int ph = 0; ph < NPHASE; ++ph) { a.ph_lo = ph; a.ph_hi = ph + 1; hipLaunchKernelGGL(yoco_fwd, dim3(grid), dim3(512), LDS_BYTES, stream, a); }
#else
    a.ph_lo = 0; a.ph_hi = nphase_total();
#if PROBE_KIND >= 0
    { int n = 0; for (int b = 0; b < NPHASE; ++b) { const int r = (base_kind(b) == PROBE_KIND) ? PROBE_REP : 1; for (int k = 0; k < r; ++k) a.tab[n++] = (unsigned char)(b | (k > 0 ? 64 : 0)); } }
#endif
    hipLaunchKernelGGL(yoco_fwd, dim3(grid), dim3(512), LDS_BYTES, stream, a);
#endif
}
```
